# Optimizing an MI355X kernel written in HIP

```python
import math
import jax, jax.numpy as jnp
from jax import lax
import numpy as np

D_MODEL = 4096
BATCH = 2
SEQ = 4096
DEPTH = 2

N_MIXERS = 2
N_ATTN_LAYERS = (DEPTH + 1) // 2
N_CONV_LAYERS = DEPTH // 2

HEAD_DIM = 128
N_HEADS = D_MODEL // HEAD_DIM
N_KV_HEADS = N_HEADS // 4
GROUP = N_HEADS // N_KV_HEADS
Q_WIDTH = N_HEADS * HEAD_DIM
KV_WIDTH = N_KV_HEADS * HEAD_DIM
WINDOW = 128
BLOCK = 128

CONV_WIDTH = 3
CONV_CH = D_MODEL

FFN_HIDDEN = int(math.ceil((8 * D_MODEL / 3) / 256) * 256)

ALPHA = (2.0 * DEPTH) ** 0.25
BETA = (8.0 * DEPTH) ** -0.25
LN_EPS = 1e-5

kernel_name = "hybrid_swa_sink_shortconv_deepnorm"


def layer_norm(x, g, b):
    xf = x.astype(jnp.float32)
    mu = jnp.mean(xf, axis=-1, keepdims=True)
    var = jnp.mean(jnp.square(xf - mu), axis=-1, keepdims=True)
    y = (xf - mu) * lax.rsqrt(var + LN_EPS)
    return (y * g.astype(jnp.float32) + b.astype(jnp.float32)).astype(x.dtype)


def _banded(t, n_blocks):
    b_, s_ = t.shape[0], t.shape[1]
    tp = jnp.pad(t, ((0, 0), (BLOCK, 0), (0, 0), (0, 0)))
    prev = tp[:, :s_].reshape(b_, n_blocks, BLOCK, N_KV_HEADS, HEAD_DIM)
    cur = t.reshape(b_, n_blocks, BLOCK, N_KV_HEADS, HEAD_DIM)
    return jnp.concatenate([prev, cur], axis=2)


def sliding_window_sink_attention(x, w_in, sinks, w_out):
    b_, s_, _ = x.shape
    nb = s_ // BLOCK
    qkv = x @ w_in
    q, k, v = jnp.split(qkv, [Q_WIDTH, Q_WIDTH + KV_WIDTH], axis=-1)
    q = q.reshape(b_, nb, BLOCK, N_KV_HEADS, GROUP, HEAD_DIM)
    kb = _banded(k.reshape(b_, s_, N_KV_HEADS, HEAD_DIM), nb)
    vb = _banded(v.reshape(b_, s_, N_KV_HEADS, HEAD_DIM), nb)

    scale = 1.0 / math.sqrt(HEAD_DIM)
    scores = jnp.einsum('bnqhgd,bnkhd->bnhgqk', q, kb).astype(jnp.float32) * scale
    qi = jnp.arange(BLOCK)[:, None]
    ki = jnp.arange(2 * BLOCK)[None, :]
    diff = qi + BLOCK - ki
    band = (diff >= 0) & (diff < WINDOW)
    key_pos = jnp.arange(nb)[:, None] * BLOCK + jnp.arange(2 * BLOCK)[None, :] - BLOCK
    mask = band[None, :, :] & (key_pos >= 0)[:, None, :]
    scores = jnp.where(mask[None, :, None, None, :, :], scores, -jnp.inf)

    sink = sinks.astype(jnp.float32).reshape(N_KV_HEADS, GROUP)[None, None, :, :, None, None]
    m = jnp.maximum(jnp.max(scores, axis=-1, keepdims=True), sink)
    p = jnp.exp(scores - m)
    denom = jnp.sum(p, axis=-1, keepdims=True) + jnp.exp(sink - m)
    probs = (p / denom).astype(vb.dtype)
    out = jnp.einsum('bnhgqk,bnkhd->bnqhgd', probs, vb).reshape(b_, s_, Q_WIDTH)
    return out @ w_out


def short_conv_mixer(x, w_in, conv_w, w_out):
    s_ = x.shape[1]
    b_gate, c_gate, h = jnp.split(x @ w_in, 3, axis=-1)
    u = c_gate * h
    up = jnp.pad(u, ((0, 0), (CONV_WIDTH - 1, 0), (0, 0)))
    conv = up[:, 0:s_] * conv_w[0]
    for j in range(1, CONV_WIDTH):
        conv = conv + up[:, j:j + s_] * conv_w[j]
    return (b_gate * conv) @ w_out


def swiglu_ffn(x, w_gate_up, w_down):
    gate, up = jnp.split(x @ w_gate_up, 2, axis=-1)
    return (jax.nn.silu(gate) * up) @ w_down


def setup_inputs(seed: int = 0) -> dict:
    key = jax.random.key(seed)
    ks = jax.random.split(key, 16)

    def normal(k, shape, scale):
        return jax.random.normal(k, shape, jnp.float32) * scale

    d = D_MODEL
    x = normal(ks[0], (BATCH, SEQ, d), 1.0)
    attn_w_in = normal(ks[1], (N_ATTN_LAYERS, d, Q_WIDTH + 2 * KV_WIDTH), d ** -0.5)
    attn_sinks = normal(ks[2], (N_ATTN_LAYERS, N_HEADS), 0.5)
    attn_w_out = normal(ks[3], (N_ATTN_LAYERS, Q_WIDTH, d), BETA * Q_WIDTH ** -0.5)
    conv_w_in = normal(ks[4], (N_CONV_LAYERS, d, 3 * CONV_CH), d ** -0.5)
    conv_w = normal(ks[5], (N_CONV_LAYERS, CONV_WIDTH, CONV_CH), CONV_WIDTH ** -0.5)
    conv_w_out = normal(ks[6], (N_CONV_LAYERS, CONV_CH, d), BETA * CONV_CH ** -0.5)
    ln_mix_g = 1.0 + normal(ks[7], (DEPTH, d), 0.02)
    ln_mix_b = normal(ks[8], (DEPTH, d), 0.02)
    ffn_w_gate_up = normal(ks[9], (DEPTH, d, 2 * FFN_HIDDEN), d ** -0.5)
    ffn_w_down = normal(ks[10], (DEPTH, FFN_HIDDEN, d), BETA * FFN_HIDDEN ** -0.5)
    ln_ffn_g = 1.0 + normal(ks[11], (DEPTH, d), 0.02)
    ln_ffn_b = normal(ks[12], (DEPTH, d), 0.02)
    return {
        "x": x,
        "attn_w_in": attn_w_in,
        "attn_sinks": attn_sinks,
        "attn_w_out": attn_w_out,
        "conv_w_in": conv_w_in,
        "conv_w": conv_w,
        "conv_w_out": conv_w_out,
        "ln_mix_g": ln_mix_g,
        "ln_mix_b": ln_mix_b,
        "ffn_w_gate_up": ffn_w_gate_up,
        "ffn_w_down": ffn_w_down,
        "ln_ffn_g": ln_ffn_g,
        "ln_ffn_b": ln_ffn_b,
    }


def reference(x, attn_w_in, attn_sinks, attn_w_out, conv_w_in, conv_w, conv_w_out,
              ln_mix_g, ln_mix_b, ffn_w_gate_up, ffn_w_down, ln_ffn_g, ln_ffn_b):
    for i in range(DEPTH):
        j = i // N_MIXERS
        if i % N_MIXERS == 0:
            mix = sliding_window_sink_attention(x, attn_w_in[j], attn_sinks[j], attn_w_out[j])
        else:
            mix = short_conv_mixer(x, conv_w_in[j], conv_w[j], conv_w_out[j])
        x = layer_norm(ALPHA * x + mix, ln_mix_g[i], ln_mix_b[i])
        ffn = swiglu_ffn(x, ffn_w_gate_up[i], ffn_w_down[i])
        x = layer_norm(ALPHA * x + ffn, ln_ffn_g[i], ln_ffn_b[i])
    return x
```

```cpp
#include <hip/hip_runtime.h>
#include <cstdio>
#include <cstdint>
#include <cmath>

#ifndef DEV_MODE
#define DEV_MODE 0
#endif
#ifndef FASTMASK
#define FASTMASK 0x7fffu
#endif

namespace pg8 {
#define PG8_LAS __attribute__((address_space(3)))
typedef unsigned short bf16_t;
typedef short bf16x8 __attribute__((ext_vector_type(8)));
typedef float f32x4 __attribute__((ext_vector_type(4)));
typedef unsigned u32x4 __attribute__((ext_vector_type(4)));
constexpr int BM = 256, BK = 64, HALF = 128, HTB = HALF * BK * 2  , STAGE_BYTES = 8 * HTB, NXCD = 8, WGM = 4;

__host__ __device__ __forceinline__ int lds_byte(int r, int c) { const int st = (r >> 4) * 2 + (c >> 5), rr = r & 15, cc = c & 31, ob = rr * 64 + cc * 2; return st * 1024 + (ob ^ (((ob >> 9) & 1) << 5)); }
__host__ __device__ __forceinline__ void stage_rc(int b, int& R, int& C) { const int st = b / 1024, sb = b % 1024, swz = sb ^ (((sb >> 9) & 1) << 5); R = (st >> 1) * 16 + swz / 64; C = (st & 1) * 32 + (swz % 64) / 2; }
__host__ __device__ __forceinline__ int perm32(int rho) { const int n = rho >> 4, i = rho & 15; return 8 * (i >> 2) + 4 * n + (i & 3); }

__host__ __device__ __forceinline__ size_t tl_off(int row, int k, int K) { return ((size_t)(row >> 8) * (size_t)(K >> 6) + (size_t)(k >> 6)) * 16384 + (size_t)(((row & 255) << 6) + (k & 63)); }
struct Unit { int pm, pn; };
struct Gemm { const bf16_t* A; const bf16_t* Bt; int M, N, K; };

struct StaticOrder {
    int nM, nN, nwg, G, c;
    __host__ __device__ void init(int M, int N, int G_, int c_) { nM = M / BM; nN = N / BM; nwg = nM * nN; G = G_; c = c_; }
    __host__ __device__ bool next(int i, Unit& u) const {
        const long L = (long)i * G + c; if (L >= nwg) return false;
        int wgid = (int)L; { const int q = nwg / NXCD, r = nwg % NXCD, xcd = wgid % NXCD, off = wgid / NXCD; wgid = (xcd < r ? xcd * (q + 1) : r * (q + 1) + (xcd - r) * q) + off; }
        const int nig = WGM * nN, gid = wgid / nig, fm = gid * WGM, gsz = (nM - fm) < WGM ? (nM - fm) : WGM;
        u.pm = fm + ((wgid % nig) % gsz); u.pn = (wgid % nig) / gsz; return true;
    }
    __device__ __forceinline__ void a_ready(const Unit&) const {}
    __device__ __forceinline__ void done(const Unit&) const {}
};

__device__ __forceinline__ unsigned cvt_pk_bf16(float lo, float hi) { unsigned r; asm volatile("v_cvt_pk_bf16_f32 %0, %1, %2" : "=v"(r) : "v"(lo), "v"(hi)); return r; }
typedef unsigned u32x2 __attribute__((ext_vector_type(2)));
typedef float f32x2 __attribute__((ext_vector_type(2)));
constexpr float LOG2E_F = 1.4426950408889634f;
__device__ __forceinline__ float silu_f(float g) { return g * __builtin_amdgcn_rcpf(1.0f + __builtin_amdgcn_exp2f(-g * LOG2E_F)); }

struct EpiBf16 {
    static constexpr bool PERM = true, AFTER_DRAIN = false;
    bf16_t* O; int ldc;
    __device__ __forceinline__ void operator()(const f32x4 (&acc)[2][2][4][2], const Unit& u, int wr, int wc, int fr, int fq) const {
        const int row0 = u.pm * BM + wr * 64 + fr, col0 = u.pn * BM + wc * 32 + 8 * fq;
#pragma unroll
        for (int ai = 0; ai < 2; ++ai)
#pragma unroll
            for (int m = 0; m < 4; ++m) { bf16_t* rowp = O + (size_t)(row0 + ai * HALF + m * 16) * ldc + col0;
#pragma unroll
                for (int bj = 0; bj < 2; ++bj) { const f32x4 v0 = acc[ai][bj][m][0], v1 = acc[ai][bj][m][1];
                    u32x4 w; w.x = cvt_pk_bf16(v0[0], v0[1]); w.y = cvt_pk_bf16(v0[2], v0[3]); w.z = cvt_pk_bf16(v1[0], v1[1]); w.w = cvt_pk_bf16(v1[2], v1[3]);
                    *(u32x4*)(rowp + bj * HALF) = w; } }
    }
};
struct EpiSwiGLU {
    static constexpr bool PERM = true, AFTER_DRAIN = false;
    bf16_t* H; int ldh;
    __device__ __forceinline__ void operator()(const f32x4 (&acc)[2][2][4][2], const Unit& u, int wr, int wc, int fr, int fq) const {
        const int row0 = u.pm * BM + wr * 64 + fr, col0 = u.pn * HALF + wc * 32 + 8 * fq;
#pragma unroll
        for (int ai = 0; ai < 2; ++ai)
#pragma unroll
            for (int m = 0; m < 4; ++m) { bf16_t* rowp = H + tl_off(row0 + ai * HALF + m * 16, col0, ldh);
                const f32x4 g0 = acc[ai][0][m][0], g1 = acc[ai][0][m][1], u0 = acc[ai][1][m][0], u1 = acc[ai][1][m][1];
                u32x4 w;
                w.x = cvt_pk_bf16(silu_f(g0[0]) * u0[0], silu_f(g0[1]) * u0[1]); w.y = cvt_pk_bf16(silu_f(g0[2]) * u0[2], silu_f(g0[3]) * u0[3]);
                w.z = cvt_pk_bf16(silu_f(g1[0]) * u1[0], silu_f(g1[1]) * u1[1]); w.w = cvt_pk_bf16(silu_f(g1[2]) * u1[2], silu_f(g1[3]) * u1[3]);
                __builtin_nontemporal_store(w, (u32x4*)rowp); }
    }
};
struct EpiConvIn {
    static constexpr bool PERM = true, AFTER_DRAIN = false;
    bf16_t* U; bf16_t* BG; int ld; int npair;
    __device__ __forceinline__ void operator()(const f32x4 (&acc)[2][2][4][2], const Unit& u, int wr, int wc, int fr, int fq) const {
        const int row0 = u.pm * BM + wr * 64 + fr;
        if (u.pn < npair) {
            const int col0 = u.pn * HALF + wc * 32 + 8 * fq;
#pragma unroll
            for (int ai = 0; ai < 2; ++ai)
#pragma unroll
                for (int m = 0; m < 4; ++m) { bf16_t* rowp = U + (size_t)(row0 + ai * HALF + m * 16) * ld + col0;
                    const f32x4 v0 = acc[ai][0][m][0] * acc[ai][1][m][0], v1 = acc[ai][0][m][1] * acc[ai][1][m][1];
                    u32x4 w; w.x = cvt_pk_bf16(v0[0], v0[1]); w.y = cvt_pk_bf16(v0[2], v0[3]); w.z = cvt_pk_bf16(v1[0], v1[1]); w.w = cvt_pk_bf16(v1[2], v1[3]);
                    *(u32x4*)rowp = w; }
        } else {
            const int col0 = (u.pn - npair) * BM + wc * 32 + 8 * fq;
#pragma unroll
            for (int ai = 0; ai < 2; ++ai)
#pragma unroll
                for (int m = 0; m < 4; ++m) { bf16_t* rowp = BG + (size_t)(row0 + ai * HALF + m * 16) * ld + col0;
#pragma unroll
                    for (int bj = 0; bj < 2; ++bj) { const f32x4 v0 = acc[ai][bj][m][0], v1 = acc[ai][bj][m][1];
                        u32x4 w; w.x = cvt_pk_bf16(v0[0], v0[1]); w.y = cvt_pk_bf16(v0[2], v0[3]); w.z = cvt_pk_bf16(v1[0], v1[1]); w.w = cvt_pk_bf16(v1[2], v1[3]);
                        *(u32x4*)(rowp + bj * HALF) = w; } }
        }
    }
};
typedef _Float16 f16x8 __attribute__((ext_vector_type(8)));
__device__ __forceinline__ unsigned cvt_pk_f16(float lo, float hi) { unsigned r; asm volatile("v_cvt_pk_f16_f32 %0, %1, %2" : "=v"(r) : "v"(lo), "v"(hi)); return r; }
struct EpiResF16 {
    static constexpr bool PERM = true, AFTER_DRAIN = false;
    const bf16_t* R; bf16_t* Y; int ldc; float alpha;
    __device__ __forceinline__ void operator()(const f32x4 (&acc)[2][2][4][2], const Unit& u, int wr, int wc, int fr, int fq) const {
        const int row0 = u.pm * BM + wr * 64 + fr, col0 = u.pn * BM + wc * 32 + 8 * fq;
#pragma unroll
        for (int ai = 0; ai < 2; ++ai) {
            u32x4 rv[4][2];
#pragma unroll
            for (int m = 0; m < 4; ++m)
#pragma unroll
                for (int bj = 0; bj < 2; ++bj) rv[m][bj] = *(const u32x4*)(R + (size_t)(row0 + ai * HALF + m * 16) * ldc + col0 + bj * HALF);
#pragma unroll
            for (int m = 0; m < 4; ++m)
#pragma unroll
                for (int bj = 0; bj < 2; ++bj) { const f16x8 hr = __builtin_bit_cast(f16x8, rv[m][bj]);
                    const f32x4 a0 = acc[ai][bj][m][0], a1 = acc[ai][bj][m][1]; u32x4 w;
                    w.x = cvt_pk_f16((float)hr[0] * alpha + a0[0], (float)hr[1] * alpha + a0[1]);
                    w.y = cvt_pk_f16((float)hr[2] * alpha + a0[2], (float)hr[3] * alpha + a0[3]);
                    w.z = cvt_pk_f16((float)hr[4] * alpha + a1[0], (float)hr[5] * alpha + a1[1]);
                    w.w = cvt_pk_f16((float)hr[6] * alpha + a1[2], (float)hr[7] * alpha + a1[3]);
                    *(u32x4*)(Y + (size_t)(row0 + ai * HALF + m * 16) * ldc + col0 + bj * HALF) = w; }
            asm volatile("" ::: "memory"); }
    }
};

struct EpiResLN {
    static constexpr bool PERM = true, AFTER_DRAIN = false;
    bf16_t* Y; int ldc; float alpha; const float* ST; const float* G; const float* B;
    __device__ __forceinline__ void operator()(const f32x4 (&acc)[2][2][4][2], const Unit& u, int wr, int wc, int fr, int fq) const {
        asm volatile("" ::: "memory");
        int fr_ = fr, fq_ = fq; asm volatile("" : "+v"(fr_), "+v"(fq_));
        const int row0 = u.pm * BM + wr * 64 + fr_, col0 = u.pn * BM + wc * 32 + 8 * fq_;
        typedef __attribute__((address_space(1))) const float gcf; typedef __attribute__((address_space(1))) const f32x4 gcf4; typedef __attribute__((address_space(1))) const f32x2 gcf2;
        gcf* Gg = (gcf*)G; gcf* Bg = (gcf*)B; gcf* STg = (gcf*)ST;
        f32x4 ga[2][2], ba[2][2];
#pragma unroll
        for (int bj = 0; bj < 2; ++bj)
#pragma unroll
            for (int n = 0; n < 2; ++n) { ga[bj][n] = *(gcf4*)(Gg + col0 + bj * HALF + 4 * n) * alpha; ba[bj][n] = *(gcf4*)(Bg + col0 + bj * HALF + 4 * n) * alpha; }
#pragma unroll
        for (int ai = 0; ai < 2; ++ai) {
            u32x4 rv[4][2]; f32x2 st[4];
#pragma unroll
            for (int m = 0; m < 4; ++m) { st[m] = *(gcf2*)(STg + 2 * (size_t)(row0 + ai * HALF + m * 16));
#pragma unroll
                for (int bj = 0; bj < 2; ++bj) rv[m][bj] = *(const u32x4*)(Y + (size_t)(row0 + ai * HALF + m * 16) * ldc + col0 + bj * HALF); }
#pragma unroll
            for (int m = 0; m < 4; ++m)
#pragma unroll
                for (int bj = 0; bj < 2; ++bj) { const f16x8 hr = __builtin_bit_cast(f16x8, rv[m][bj]); const float mu = st[m].x, rs = st[m].y;
                    const f32x4 a0 = acc[ai][bj][m][0], a1 = acc[ai][bj][m][1], g0 = ga[bj][0], g1 = ga[bj][1], b0 = ba[bj][0], b1 = ba[bj][1]; u32x4 w;
                    w.x = cvt_pk_f16(((float)hr[0] - mu) * rs * g0[0] + (b0[0] + a0[0]), ((float)hr[1] - mu) * rs * g0[1] + (b0[1] + a0[1]));
                    w.y = cvt_pk_f16(((float)hr[2] - mu) * rs * g0[2] + (b0[2] + a0[2]), ((float)hr[3] - mu) * rs * g0[3] + (b0[3] + a0[3]));
                    w.z = cvt_pk_f16(((float)hr[4] - mu) * rs * g1[0] + (b1[0] + a1[0]), ((float)hr[5] - mu) * rs * g1[1] + (b1[1] + a1[1]));
                    w.w = cvt_pk_f16(((float)hr[6] - mu) * rs * g1[2] + (b1[2] + a1[2]), ((float)hr[7] - mu) * rs * g1[3] + (b1[3] + a1[3]));
                    *(u32x4*)(Y + (size_t)(row0 + ai * HALF + m * 16) * ldc + col0 + bj * HALF) = w; }
            asm volatile("" ::: "memory"); }
    }
};

template <class Epi, class Sched, bool ALIGN_EPI = false, bool SP2 = false>
__device__ __forceinline__ void gemm_phase(PG8_LAS unsigned char* lds, const Gemm g, const Sched& S, const Epi& E) {
    int tid_ = threadIdx.x; asm volatile("" : "+v"(tid_));
    const int tid = tid_, wid = __builtin_amdgcn_readfirstlane(tid >> 6), lane = tid & 63, wr = wid >> 2, wc = wid & 3, fr = lane & 15, fq = lane >> 4;
    const int K = g.K, nt = K / BK;
    unsigned voffA[2], voffB[2];
#pragma unroll
    for (int i = 0; i < 2; ++i) { int R, C; stage_rc(tid * 16 + i * 8192, R, C); const int Rb = Epi::PERM ? ((R & ~31) + perm32(R & 31)) : R;
        voffA[i] = (unsigned)(R * BK + C) * 2u; voffB[i] = (unsigned)(Rb * BK + C) * 2u; }
    const size_t kstep = (size_t)BM * BK * 2;
    const size_t hstep = (size_t)HALF * BK * 2;
    const size_t tstep = (size_t)BM * K * 2;
    const unsigned ldsw = (unsigned)wid * 1024u;
    const int aoff = lds_byte(wr * 64 + fr, fq * 8), boff = lds_byte(wc * 32 + fr, fq * 8);
#define PG8_SA(b, h) (((b) * 2 + (h)) * HTB)
#define PG8_SB(b, h) ((4 + (b) * 2 + (h)) * HTB)
#define PG8_STAGE(bufoff, gbase, voff) do { _Pragma("unroll") for (int _i = 0; _i < 2; ++_i) \
        __builtin_amdgcn_global_load_lds((const unsigned*)((const char*)(gbase) + (voff)[_i]), (PG8_LAS unsigned*)(lds + (bufoff) + ldsw + _i * 8192), 16, 0, 0); } while (0)
#define PG8_LDA(dst, b, h) do { _Pragma("unroll") for (int m = 0; m < 4; ++m) _Pragma("unroll") for (int k = 0; k < 2; ++k) dst[m][k] = *(const PG8_LAS bf16x8*)(lds + PG8_SA(b, h) + aoff + m * 2048 + k * 1024); } while (0)
#define PG8_LDB(dst, b, h) do { _Pragma("unroll") for (int n = 0; n < 2; ++n) _Pragma("unroll") for (int k = 0; k < 2; ++k) dst[n][k] = *(const PG8_LAS bf16x8*)(lds + PG8_SB(b, h) + boff + n * 2048 + k * 1024); } while (0)
#define PG8_MMA(ai, bj, At, Bt) do { __builtin_amdgcn_s_setprio(1); _Pragma("unroll") for (int m = 0; m < 4; ++m) _Pragma("unroll") for (int n = 0; n < 2; ++n) _Pragma("unroll") for (int k = 0; k < 2; ++k) \
        acc[ai][bj][m][n] = __builtin_amdgcn_mfma_f32_16x16x32_bf16(Bt[n][k], At[m][k], acc[ai][bj][m][n], 0, 0, 0); __builtin_amdgcn_s_setprio(0); } while (0)
#define PG8_WAIT_V(n) asm volatile("s_waitcnt vmcnt(" #n ")" ::: "memory")
#define PG8_WAIT_L(n) asm volatile("s_waitcnt lgkmcnt(" #n ")" ::: "memory")
#define PG8_BAR __builtin_amdgcn_s_barrier()
#define PG8_SCHED __builtin_amdgcn_sched_barrier(0)
    Unit cur, nxt; int ui = 0;
    if (!S.next(0, cur)) return;
    f32x4 acc[2][2][4][2];
#pragma unroll
    for (int a = 0; a < 2; ++a)
#pragma unroll
        for (int b = 0; b < 2; ++b)
#pragma unroll
            for (int m = 0; m < 4; ++m)
#pragma unroll
                for (int n = 0; n < 2; ++n) acc[a][b][m][n] = (f32x4){0.f, 0.f, 0.f, 0.f};
    bf16x8 At[4][2], B0[2][2], B1[2][2];
    const char* cA = (const char*)g.A + (size_t)cur.pm * tstep; const char* cB = (const char*)g.Bt + (size_t)cur.pn * tstep;
    S.a_ready(cur);
    if constexpr (SP2) {
        PG8_STAGE(PG8_SB(0, 0), cB, voffB); PG8_STAGE(PG8_SB(0, 1), cB + hstep, voffB); PG8_STAGE(PG8_SA(0, 0), cA, voffA); PG8_STAGE(PG8_SA(0, 1), cA + hstep, voffA);
        if (wr == 1) PG8_BAR;
        PG8_WAIT_V(2); PG8_BAR;
        PG8_STAGE(PG8_SB(1, 0), cB + kstep, voffB); PG8_STAGE(PG8_SA(1, 0), cA + kstep, voffA); PG8_STAGE(PG8_SB(1, 1), cB + hstep + kstep, voffB);
        PG8_WAIT_V(6); PG8_BAR;
    } else {
        PG8_STAGE(PG8_SB(0, 0), cB, voffB); PG8_STAGE(PG8_SA(0, 0), cA, voffA); PG8_STAGE(PG8_SB(0, 1), cB + hstep, voffB); PG8_STAGE(PG8_SA(0, 1), cA + hstep, voffA);
        if (wr == 1) PG8_BAR;
        PG8_WAIT_V(4); PG8_BAR;
        PG8_STAGE(PG8_SB(1, 0), cB + kstep, voffB); PG8_STAGE(PG8_SA(1, 0), cA + kstep, voffA); PG8_STAGE(PG8_SB(1, 1), cB + hstep + kstep, voffB);
        PG8_WAIT_V(6); PG8_BAR;
    }
    for (;;) {
        const bool has_next = S.next(ui + 1, nxt);
        const char* nA = has_next ? (const char*)g.A + (size_t)nxt.pm * tstep : cA; const char* nB = has_next ? (const char*)g.Bt + (size_t)nxt.pn * tstep : cB;
        for (int t = 0; t < nt; t += 2) {
            const bool last = (t == nt - 2);
            const char* a1 = cA + (size_t)(t + 1) * kstep;
            const char* a2 = last ? nA : cA + (size_t)(t + 2) * kstep; const char* b2 = last ? nB : cB + (size_t)(t + 2) * kstep;
            const char* a3 = a2 + kstep; const char* b3 = b2 + kstep;
            if (last && has_next) S.a_ready(nxt);
            if constexpr (SP2) {
            PG8_LDB(B0, 0, 0); PG8_LDB(B1, 0, 1); PG8_SCHED; PG8_LDA(At, 0, 0); PG8_STAGE(PG8_SA(1, 1), a1 + hstep, voffA);
            PG8_WAIT_V(8); PG8_WAIT_L(0); PG8_BAR; PG8_MMA(0, 0, At, B0); PG8_MMA(0, 1, At, B1); PG8_BAR; PG8_SCHED;
            PG8_LDA(At, 0, 1); PG8_STAGE(PG8_SB(0, 0), b2, voffB); PG8_STAGE(PG8_SB(0, 1), b2 + hstep, voffB); PG8_STAGE(PG8_SA(0, 0), a2, voffA);
            PG8_WAIT_V(8); PG8_WAIT_L(0); PG8_BAR; PG8_MMA(1, 0, At, B0); PG8_MMA(1, 1, At, B1); PG8_BAR; PG8_SCHED;
            PG8_LDB(B0, 1, 0); PG8_LDB(B1, 1, 1); PG8_SCHED; PG8_LDA(At, 1, 0); PG8_STAGE(PG8_SA(0, 1), a2 + hstep, voffA);
            PG8_WAIT_V(8); PG8_WAIT_L(0); PG8_BAR; PG8_MMA(0, 0, At, B0); PG8_MMA(0, 1, At, B1); PG8_BAR; PG8_SCHED;
            PG8_LDA(At, 1, 1); PG8_STAGE(PG8_SB(1, 0), b3, voffB); PG8_STAGE(PG8_SB(1, 1), b3 + hstep, voffB); PG8_STAGE(PG8_SA(1, 0), a3, voffA);
            PG8_WAIT_V(8); PG8_WAIT_L(0); PG8_BAR; PG8_MMA(1, 0, At, B0); PG8_MMA(1, 1, At, B1); PG8_BAR; PG8_SCHED;
            } else {
            PG8_LDB(B0, 0, 0); PG8_SCHED; PG8_LDA(At, 0, 0); PG8_STAGE(PG8_SA(1, 1), a1 + hstep, voffA);
            PG8_WAIT_L(8); PG8_BAR; PG8_WAIT_L(0); PG8_MMA(0, 0, At, B0); PG8_BAR; PG8_SCHED;
            PG8_LDB(B1, 0, 1); PG8_STAGE(PG8_SB(0, 0), b2, voffB);
            PG8_BAR; PG8_WAIT_L(0); PG8_MMA(0, 1, At, B1); PG8_BAR;
            PG8_LDA(At, 0, 1); PG8_STAGE(PG8_SA(0, 0), a2, voffA);
            PG8_BAR; PG8_WAIT_L(0); PG8_MMA(1, 0, At, B0); PG8_BAR; PG8_SCHED;
            PG8_STAGE(PG8_SB(0, 1), b2 + hstep, voffB);
            PG8_WAIT_V(6); PG8_BAR; PG8_MMA(1, 1, At, B1); PG8_BAR;
            PG8_LDB(B0, 1, 0); PG8_SCHED; PG8_LDA(At, 1, 0); PG8_STAGE(PG8_SA(0, 1), a2 + hstep, voffA);
            PG8_WAIT_L(8); PG8_BAR; PG8_WAIT_L(0); PG8_MMA(0, 0, At, B0); PG8_BAR; PG8_SCHED;
            PG8_LDB(B1, 1, 1); PG8_STAGE(PG8_SB(1, 0), b3, voffB);
            PG8_BAR; PG8_WAIT_L(0); PG8_MMA(0, 1, At, B1); PG8_BAR;
            PG8_LDA(At, 1, 1); PG8_STAGE(PG8_SA(1, 0), a3, voffA);
            PG8_BAR; PG8_WAIT_L(0); PG8_MMA(1, 0, At, B0); PG8_BAR; PG8_SCHED;
            PG8_STAGE(PG8_SB(1, 1), b3 + hstep, voffB);
            PG8_WAIT_V(6); PG8_BAR; PG8_MMA(1, 1, At, B1); PG8_BAR;
            }
        }
        if constexpr (ALIGN_EPI) { if (wr == 0) PG8_BAR; }
        if constexpr (!Epi::AFTER_DRAIN) { E(acc, cur, wr, wc, fr, fq); S.done(cur); }
        if (!has_next) break;
#pragma unroll
        for (int a = 0; a < 2; ++a)
#pragma unroll
            for (int b = 0; b < 2; ++b)
#pragma unroll
                for (int m = 0; m < 4; ++m)
#pragma unroll
                    for (int n = 0; n < 2; ++n) acc[a][b][m][n] = (f32x4){0.f, 0.f, 0.f, 0.f};
        cur = nxt; cA = nA; cB = nB; ++ui;
        if constexpr (ALIGN_EPI) { if (wr == 1) PG8_BAR; }
    }
    PG8_WAIT_V(0);
    if constexpr (!ALIGN_EPI) { if (wr == 0) PG8_BAR; }
    PG8_BAR;
    if constexpr (Epi::AFTER_DRAIN) { E.fused(acc, cur, wr, wc, fr, fq, lds, wid, lane); S.done(cur); }
#undef PG8_SA
#undef PG8_SB
#undef PG8_STAGE
#undef PG8_LDA
#undef PG8_LDB
#undef PG8_MMA
#undef PG8_WAIT_V
#undef PG8_WAIT_L
#undef PG8_BAR
#undef PG8_SCHED
}
}

constexpr int NWAVES = 8;
constexpr int BATCH = 2, SEQ = 4096, DM = 4096, M = BATCH * SEQ;
constexpr int NHEAD = 32, NKVH = 8, HD = 128, NQ = 4096, NKV = 1024, NQK = NQ + NKV, NQKV = NQ + 2 * NKV;
constexpr int FFH = 11008, NGU = 2 * FFH, NCI = 3 * DM;
constexpr float ALPHA = 1.4142135623730951f;
constexpr float LN_EPS = 1e-5f;
constexpr int NPHASE = 15;

constexpr size_t MiB = 1u << 20;
constexpr size_t WS_CTL = 0, CTL_ZERO_BYTES = 1 * MiB;
constexpr size_t WS_WQKV = 2 * MiB;
constexpr size_t WS_WV = WS_WQKV + (size_t)NQK * DM * 2;
constexpr size_t WS_WO = 50 * MiB;
constexpr size_t WS_WCI = 82 * MiB;
constexpr size_t WS_WCO = 178 * MiB;
constexpr size_t WS_WGU0 = 210 * MiB, WS_WGU1 = 382 * MiB;
constexpr size_t WS_WD0 = 554 * MiB, WS_WD1 = 640 * MiB;
constexpr size_t WS_XB = 726 * MiB;
constexpr size_t WS_QK = 790 * MiB;
constexpr size_t WS_VT = 870 * MiB;
constexpr size_t WS_O = 886 * MiB;
constexpr size_t WS_Y = 950 * MiB;
constexpr size_t WS_X = 1078 * MiB;
constexpr size_t WS_ST = WS_X + 64 * MiB;
constexpr size_t WS_H = 1206 * MiB;
constexpr size_t WS_U = 1378 * MiB, WS_BG = 1442 * MiB;
constexpr size_t WS_C = 1506 * MiB;
constexpr size_t WS_END = 2194 * MiB;
static_assert(WS_WV + (size_t)NKV * DM * 2 == WS_WO && WS_WO + (size_t)DM * DM * 2 == WS_WCI && WS_WCI + (size_t)NCI * DM * 2 == WS_WCO && WS_WCO + (size_t)DM * DM * 2 == WS_WGU0, "ws map 1");
static_assert(WS_WGU0 + (size_t)NGU * DM * 2 == WS_WGU1 && WS_WGU1 + (size_t)NGU * DM * 2 == WS_WD0 && WS_WD0 + (size_t)DM * FFH * 2 == WS_WD1 && WS_WD1 + (size_t)DM * FFH * 2 == WS_XB, "ws map 2");
static_assert(WS_XB + (size_t)M * DM * 2 == WS_QK && WS_QK + (size_t)M * NQK * 2 == WS_VT && WS_VT + (size_t)NKV * M * 2 == WS_O && WS_O + (size_t)M * DM * 2 == WS_Y && WS_Y + (size_t)M * DM * 4 == WS_X, "ws map 3");
static_assert(WS_X + (size_t)M * DM * 4 == WS_H && WS_H + (size_t)M * FFH * 2 == WS_U && WS_U + (size_t)M * DM * 2 == WS_BG && WS_BG + (size_t)M * DM * 2 == WS_C && WS_C + (size_t)M * NGU * 4 == WS_END, "ws map 4");
constexpr int CW_TMO = 0;
constexpr int CW_GRP = 32768, N_GSEAM = 11, GRP_SIZE = 8;
static_assert((CW_GRP + N_GSEAM * 32 * 64) * 4 <= (int)CTL_ZERO_BYTES, "CTL words inside the memset region");
constexpr int CW_BAR = 4096;

constexpr int RING_OFF = 0, RING_BYTES = 131072;
constexpr int LDSCTL_OFF = RING_BYTES, MISC_OFF = LDSCTL_OFF + 320;
constexpr int LDS_BYTES = 147456;

#define GAS __attribute__((address_space(1)))
#define LAS __attribute__((address_space(3)))
typedef unsigned short bf16;
typedef unsigned v4u __attribute__((ext_vector_type(4)));
typedef unsigned v2u __attribute__((ext_vector_type(2)));
typedef float f32x4 __attribute__((ext_vector_type(4)));
typedef float f32x16 __attribute__((ext_vector_type(16)));
typedef short bf16x8 __attribute__((ext_vector_type(8)));
typedef GAS unsigned gu32;
#define RLX_AGENT __ATOMIC_RELAXED, __HIP_MEMORY_SCOPE_AGENT
#define LDS_WAIT() asm volatile("s_waitcnt lgkmcnt(0)" ::: "memory")
typedef float f32x2 __attribute__((ext_vector_type(2)));
typedef __bf16 bf16x2_t __attribute__((ext_vector_type(2)));
__device__ __forceinline__ unsigned pk2(float lo, float hi) { const f32x2 v = {lo, hi}; return __builtin_bit_cast(unsigned, __builtin_convertvector(v, bf16x2_t)); }
__device__ __forceinline__ unsigned f2bf(float f) { return pk2(f, 0.f) & 0xffffu; }
__device__ __forceinline__ float bf2f(unsigned h) { return __builtin_bit_cast(float, h << 16); }
typedef _Float16 f16x2 __attribute__((ext_vector_type(2)));
__device__ __forceinline__ unsigned pk2h(float lo, float hi) { const f32x2 v = {lo, hi}; return __builtin_bit_cast(unsigned, __builtin_convertvector(v, f16x2)); }
__device__ __forceinline__ float h2f(unsigned h) { return (float)__builtin_bit_cast(_Float16, (unsigned short)h); }
#define MFMA32(a, b, c) __builtin_amdgcn_mfma_f32_32x32x16_bf16((a), (b), (c), 0, 0, 0)

namespace att {
typedef bf16x8 h16x8q;
constexpr int K_OFF = 0, VT_OFF = 65536;
constexpr float LOG2E = 1.4426950408889634f;
__device__ __forceinline__ void attn_unit(LAS unsigned char* lds, const bf16* __restrict__ QK, const bf16* __restrict__ VT, bf16* __restrict__ O, const float* __restrict__ sinks, int b, int g, int qb) {
    int tid_ = threadIdx.x; asm volatile("" : "+v"(tid_));
    const int tid = tid_, lane = tid & 63, r32 = lane & 31, hi = lane >> 5; const int wid = __builtin_amdgcn_readfirstlane(tid >> 6);
    const int q0 = qb * 128; const long rowbase = (long)b * SEQ;
    const int hh = wid >> 1, h = g * 4 + hh;
    h16x8q qf2[2][8];
#pragma unroll
    for (int t = 0; t < 2; ++t) { const bf16* qp = QK + (size_t)(rowbase + q0 + 32 * (2 * (wid & 1) + t) + r32) * NQK + h * HD + hi * 8;
#pragma unroll
        for (int ds = 0; ds < 8; ++ds) qf2[t][ds] = *(const h16x8q*)(qp + 16 * ds); }
    __syncthreads();
#pragma unroll
    for (int it = 0; it < 8; ++it) { const int idx = it * 512 + tid, key = idx >> 4, c = idx & 15; int pos = q0 - 128 + key; if (pos < 0) pos += 128;
        const v4u v = *(const v4u*)(QK + (size_t)(rowbase + pos) * NQK + NQ + g * HD + c * 8);
        *(LAS v4u*)(lds + K_OFF + key * 256 + ((c ^ (key & 15)) << 4)) = v; }
#pragma unroll
    for (int it = 0; it < 8; ++it) { const int idx = it * 512 + tid, d = idx >> 5, c = idx & 31; int pos = q0 - 128 + c * 8; if (pos < 0) pos += 128;
        const v4u v = *(const v4u*)(VT + (size_t)(g * HD + d) * M + rowbase + pos);
        *(LAS v4u*)(lds + VT_OFF + d * 512 + ((c ^ (d & 15)) << 4)) = v; }
    __syncthreads();
    const float sink2 = sinks[h] * LOG2E, sc = 0.08838834764831845f * LOG2E;
    const int pi = (r32 & ~12) | ((r32 & 4) << 1) | ((r32 & 8) >> 1);
#pragma unroll
    for (int t = 0; t < 2; ++t) {
        const int j = 2 * (wid & 1) + t;
        const h16x8q (&qf)[8] = qf2[t];
        f32x16 st[5];
#pragma unroll
        for (int kt = 0; kt < 5; ++kt) {
#pragma unroll
            for (int r = 0; r < 16; ++r) st[kt][r] = 0.f;
            const int kr = 32 * (j + kt) + pi; const LAS unsigned char* kp = lds + K_OFF + kr * 256;
#pragma unroll
            for (int ds = 0; ds < 8; ++ds) { const int c = 2 * ds + hi; const bf16x8 kf = *(const LAS bf16x8*)(kp + ((c ^ (kr & 15)) << 4)); st[kt] = MFMA32(kf, qf[ds], st[kt]); }
        }
        float mx = sink2;
#pragma unroll
        for (int kt = 0; kt < 5; ++kt)
#pragma unroll
            for (int r = 0; r < 16; ++r) { const int i = 16 * (r >> 3) + 8 * hi + (r & 7);
                bool ok = true; if (kt == 0) ok = i > r32; if (kt == 4) ok = i <= r32; if (q0 == 0 && j + kt < 4) ok = false;
                const float s = ok ? st[kt][r] * sc : -INFINITY; st[kt][r] = s; mx = fmaxf(mx, s); }
        mx = fmaxf(mx, __shfl_xor(mx, 32));
        float sum = 0.f;
#pragma unroll
        for (int kt = 0; kt < 5; ++kt)
#pragma unroll
            for (int r = 0; r < 16; ++r) { const float p = __builtin_amdgcn_exp2f(st[kt][r] - mx); st[kt][r] = p; sum += p; }
        sum += __shfl_xor(sum, 32);
        const float inv = 1.0f / (sum + __builtin_amdgcn_exp2f(sink2 - mx));
        bf16x8 pb[5][2];
#pragma unroll
        for (int kt = 0; kt < 5; ++kt)
#pragma unroll
            for (int m = 0; m < 2; ++m) { v4u w; w.x = pk2(st[kt][8 * m], st[kt][8 * m + 1]); w.y = pk2(st[kt][8 * m + 2], st[kt][8 * m + 3]); w.z = pk2(st[kt][8 * m + 4], st[kt][8 * m + 5]); w.w = pk2(st[kt][8 * m + 6], st[kt][8 * m + 7]);
                pb[kt][m] = __builtin_bit_cast(bf16x8, w); }
        const int orow = (int)rowbase + q0 + 32 * j + r32;
#pragma unroll
        for (int db = 0; db < 4; ++db) {
            f32x16 o;
#pragma unroll
            for (int r = 0; r < 16; ++r) o[r] = 0.f;
            const int d = 32 * db + r32; const LAS unsigned char* vp = lds + VT_OFF + d * 512;
#pragma unroll
            for (int kt = 0; kt < 5; ++kt)
#pragma unroll
                for (int m = 0; m < 2; ++m) { const int c = 4 * (j + kt) + 2 * m + hi; const bf16x8 vf = *(const LAS bf16x8*)(vp + ((c ^ (d & 15)) << 4)); o = MFMA32(vf, pb[kt][m], o); }
#pragma unroll
            for (int rg = 0; rg < 4; ++rg) { v2u w; w.x = pk2(o[4 * rg] * inv, o[4 * rg + 1] * inv); w.y = pk2(o[4 * rg + 2] * inv, o[4 * rg + 3] * inv);
                *(v2u*)(O + pg8::tl_off(orow, h * HD + 32 * db + 8 * rg + 4 * hi, NQ)) = w; }
        }
        asm volatile("" ::: "memory"); __builtin_amdgcn_sched_barrier(0);
    }
}
}

#define XB_TMO      128
#define XB_XCNT(j)  (256  + 64 * (j))
#define XB_XSUB(j)  (1280 + 64 * (j))
#define XB_XGEN(j)  (2304 + 64 * (j))
#define XB_TOP      3328
#define XB_TOPGEN   3392
#define XCD_BAR_WORDS 3456
#define XB_SPIN_CAP (1u << 18)

__device__ __forceinline__ unsigned xb_ld(unsigned* p)              { return __hip_atomic_load(p, __ATOMIC_RELAXED, __HIP_MEMORY_SCOPE_AGENT); }
__device__ __forceinline__ unsigned xb_add(unsigned* p, unsigned v) { return __hip_atomic_fetch_add(p, v, __ATOMIC_RELAXED, __HIP_MEMORY_SCOPE_AGENT); }
__device__ __forceinline__ unsigned xb_xcc_id() { return (unsigned)__builtin_amdgcn_s_getreg((3 << 11) | 20) & 0xFu; }
#define XB_SPIN(cond, bar) do { unsigned _sp = 0; while (cond) { __builtin_amdgcn_s_sleep(1); \
    if ((++_sp & 255u) == 0u) { if (xb_ld(&(bar)[XB_TMO])) break; if (_sp > XB_SPIN_CAP) { atomicAdd(&(bar)[XB_TMO], 1u); break; } } } } while (0)

struct XcdBarrier {
    unsigned* bar; unsigned x;
    unsigned rank;
    volatile LAS unsigned* st;
};

__device__ __forceinline__ XcdBarrier xcd_barrier_post(unsigned* bar, volatile LAS unsigned* st) {
    XcdBarrier b; b.bar = bar; b.x = xb_xcc_id(); b.st = st; b.rank = 0u;
    if (threadIdx.x == 0) b.rank = xb_add(&bar[XB_XCNT(b.x)], 1u);
    return b;
}
__device__ __forceinline__ void xcd_barrier_complete(unsigned* bar, unsigned x, unsigned& nloc, unsigned& nx) {
    const unsigned G = gridDim.x * gridDim.y * gridDim.z;
    unsigned sum, cnt, mine, sp = 0u;
    for (;;) {
        sum = 0u; cnt = 0u; mine = 0u;
#pragma unroll
        for (unsigned j = 0; j < 16; ++j) { const unsigned c = xb_ld(&bar[XB_XCNT(j)]); sum += c; cnt += (c > 0u) ? 1u : 0u; mine = (j == x) ? c : mine; }
        if (sum == G) break;
        __builtin_amdgcn_s_sleep(1);
        if ((++sp & 255u) == 0u) { if (xb_ld(&bar[XB_TMO])) break; if (sp > XB_SPIN_CAP) { atomicAdd(&bar[XB_TMO], 1u); break; } }
    }
    nloc = mine > 0u ? mine : 1u; nx = cnt > 0u ? cnt : 1u;
}

__device__ __forceinline__ void xcd_barrier(const XcdBarrier& b) {
    asm volatile("s_waitcnt vmcnt(0)" ::: "memory");
    __syncthreads();
    if (threadIdx.x == 0) {
        unsigned* bar = b.bar;
        __builtin_amdgcn_s_waitcnt(0);
        unsigned nloc = b.st[0], nx = b.st[1];
        if (nloc == 0u) { xcd_barrier_complete(bar, b.x, nloc, nx); b.st[0] = nloc; b.st[1] = nx; }
        const unsigned old = xb_add(&bar[XB_XSUB(b.x)], 1u);
        const unsigned gen = old / nloc;
        if (old + 1u == (gen + 1u) * nloc) {
            __builtin_amdgcn_fence(__ATOMIC_RELEASE, "agent");
            asm volatile("s_waitcnt vmcnt(0)" ::: "memory");
            const unsigned og = xb_add(&bar[XB_TOP], 1u);
            const unsigned tg = og / nx;
            if (og + 1u == (tg + 1u) * nx) xb_add(&bar[XB_TOPGEN], 1u);
            else XB_SPIN(xb_ld(&bar[XB_TOPGEN]) == tg, bar);
            __builtin_amdgcn_fence(__ATOMIC_ACQUIRE, "agent");
            xb_add(&bar[XB_XGEN(b.x)], 1u);
            asm volatile("s_waitcnt vmcnt(0)" ::: "memory");
        } else {
            XB_SPIN(xb_ld(&bar[XB_XGEN(b.x)]) == gen, bar);
            __builtin_amdgcn_fence(__ATOMIC_ACQUIRE, "agent");
            asm volatile("s_waitcnt vmcnt(0)" ::: "memory");
        }
    }
    __syncthreads();
}


struct Frame {
    LAS unsigned char* lds;
    volatile LAS unsigned* MISC;
    gu32* ctl;
    int tid, wave, vcu, G;
};
__device__ __forceinline__ float wave_sum(float v) {
#pragma unroll
    for (int o = 1; o < 64; o <<= 1) v += __shfl_xor(v, o);
    return v;
}
__device__ __forceinline__ void group_barrier(Frame& F, int seam, int pm) {
    asm volatile("s_waitcnt vmcnt(0)" ::: "memory");
    __syncthreads();
    if (F.tid == 0) {
        gu32* cnt = F.ctl + CW_GRP + (seam * 32 + pm) * 64;
        (void)__hip_atomic_fetch_add(cnt, 1u, RLX_AGENT);
        unsigned sp = 0;
        while (__hip_atomic_load(cnt, RLX_AGENT) < (unsigned)GRP_SIZE) { __builtin_amdgcn_s_sleep(1);
            if ((++sp & 255u) == 0u) { if (__hip_atomic_load(F.ctl + CW_TMO, RLX_AGENT)) break; if (sp > (1u << 18)) { __hip_atomic_store(F.ctl + CW_TMO, 1u, RLX_AGENT); break; } } }
        __builtin_amdgcn_fence(__ATOMIC_ACQUIRE, "agent");
        asm volatile("s_waitcnt vmcnt(0)" ::: "memory");
    }
    __syncthreads();
}
struct TItem { const float* W; bf16* WT; int K, N, k0, n0, drow0; };
__device__ __forceinline__ void t_load(const TItem& I, f32x4 (&ra)[8], f32x4 (&rb)[8], int lane) {
    const int q = lane & 15, pr = lane >> 4;
#pragma unroll
    for (int i = 0; i < 8; ++i) { const GAS float* src = (const GAS float*)I.W + (size_t)(I.k0 + 2 * (4 * i + pr)) * I.N + I.n0 + 4 * q; ra[i] = __builtin_nontemporal_load((const GAS f32x4*)src); rb[i] = __builtin_nontemporal_load((const GAS f32x4*)(src + I.N)); }
}
__device__ __forceinline__ void t_write_lds(LAS unsigned* T, const f32x4 (&ra)[8], const f32x4 (&rb)[8], int lane) {
    const int q = lane & 15, pr = lane >> 4;
#pragma unroll
    for (int i = 0; i < 8; ++i) { const int p = 4 * i + pr; v4u u; u.x = pk2(ra[i].x, rb[i].x); u.y = pk2(ra[i].y, rb[i].y); u.z = pk2(ra[i].z, rb[i].z); u.w = pk2(ra[i].w, rb[i].w);
        *(LAS v4u*)(T + p * 64 + ((q ^ ((p >> 2) & 7)) << 2)) = u; }
}
__device__ __forceinline__ void t_read_store(const LAS unsigned* T, const TItem& I, int lane) {
    const int c = lane & 7, nb = lane >> 3;
#pragma unroll
    for (int jj = 0; jj < 8; ++jj) { const int n = nb + 8 * jj, q = n >> 2, j = n & 3; const LAS unsigned* s = T + (4 * c) * 64 + ((q ^ c) << 2) + j;
        v4u o; o.x = s[0]; o.y = s[64]; o.z = s[128]; o.w = s[192];
        __builtin_nontemporal_store(o, (GAS v4u*)(I.WT + pg8::tl_off(I.drow0 + n, I.k0 + 8 * c, I.K))); }
}
__device__ __forceinline__ int map_pair128(int n, int half_n) {
    const int second = n >= half_n ? 1 : 0, nn = n - second * half_n; return (nn >> 7) * 256 + second * 128 + (nn & 127);
}
struct Ptrs {
    const float *x, *attn_w_in, *attn_sinks, *attn_w_out, *conv_w_in, *conv_w, *conv_w_out, *ln_mix_g, *ln_mix_b, *ffn_w_gate_up, *ffn_w_down, *ln_ffn_g, *ln_ffn_b;
    float* out; unsigned char* ws;
};
__device__ __forceinline__ void p0_prologue(Frame& F, const Ptrs& P) {
    const int lane = (int)(threadIdx.x & 63u);
    LAS unsigned* T = (LAS unsigned*)(F.lds + RING_OFF + F.wave * 8192);
    const int gw = F.vcu * NWAVES + F.wave, NGW = F.G * NWAVES;
    unsigned char* ws = P.ws;
    constexpr int I_AIN = (DM / 64) * (NQKV / 64), I_SQ = (DM / 64) * (DM / 64), I_CI = (DM / 64) * (NCI / 64), I_GU = (DM / 64) * (NGU / 64), I_DN = (FFH / 64) * (DM / 64);
    constexpr int NITEMS = I_AIN + 2 * I_SQ + I_CI + 2 * I_GU + 2 * I_DN;
    auto decode = [&](int it, TItem& I) {
        int r = it;
        if (r < 2 * I_GU) { const int l = r / I_GU; r -= l * I_GU; const int nb = NGU / 64; I.K = DM; I.N = NGU; I.k0 = 64 * (r / nb); I.n0 = 64 * (r % nb); I.drow0 = map_pair128(I.n0, FFH);
            I.W = P.ffn_w_gate_up + (size_t)l * DM * NGU; I.WT = (bf16*)(ws + (l ? WS_WGU1 : WS_WGU0)); return; } r -= 2 * I_GU;
        if (r < 2 * I_DN) { const int l = r / I_DN; r -= l * I_DN; const int nb = DM / 64; I.K = FFH; I.N = DM; I.k0 = 64 * (r / nb); I.n0 = 64 * (r % nb); I.drow0 = I.n0;
            I.W = P.ffn_w_down + (size_t)l * FFH * DM; I.WT = (bf16*)(ws + (l ? WS_WD1 : WS_WD0)); return; } r -= 2 * I_DN;
        if (r < I_CI) { const int nb = NCI / 64; I.K = DM; I.N = NCI; I.k0 = 64 * (r / nb); I.n0 = 64 * (r % nb);
            I.drow0 = I.n0 < DM ? 2 * DM + I.n0 : map_pair128(I.n0 - DM, DM);
            I.W = P.conv_w_in; I.WT = (bf16*)(ws + WS_WCI); return; } r -= I_CI;
        if (r < I_SQ) { const int nb = DM / 64; I.K = DM; I.N = DM; I.k0 = 64 * (r / nb); I.n0 = 64 * (r % nb); I.drow0 = I.n0; I.W = P.conv_w_out; I.WT = (bf16*)(ws + WS_WCO); return; } r -= I_SQ;
        if (r < I_SQ) { const int nb = DM / 64; I.K = DM; I.N = DM; I.k0 = 64 * (r / nb); I.n0 = 64 * (r % nb); I.drow0 = I.n0; I.W = P.attn_w_out; I.WT = (bf16*)(ws + WS_WO); return; } r -= I_SQ;
        { const int nb = NQKV / 64; I.K = DM; I.N = NQKV; I.k0 = 64 * (r / nb); I.n0 = 64 * (r % nb); I.drow0 = I.n0; I.W = P.attn_w_in; I.WT = (bf16*)(ws + WS_WQKV); }
    };
    {
        int it = gw; TItem cur, nxt; f32x4 ra[8], rb[8];
        if (it < NITEMS) { decode(it, cur); t_load(cur, ra, rb, lane); }
        while (it < NITEMS) {
            t_write_lds(T, ra, rb, lane);
            const int nit = it + NGW;
            if (nit < NITEMS) { decode(nit, nxt); t_load(nxt, ra, rb, lane); }
            LDS_WAIT(); asm volatile("" ::: "memory");
            t_read_store(T, cur, lane);
            LDS_WAIT(); asm volatile("" ::: "memory");
            cur = nxt; it = nit;
        }
    }
    { const size_t nchunk = (size_t)M * DM / 8; const size_t gt = (size_t)(F.vcu * NWAVES + F.wave) * 64 + lane, NT = (size_t)F.G * NWAVES * 64;
      const GAS f32x4* xs = (const GAS f32x4*)P.x; GAS v4u* xh = (GAS v4u*)(ws + WS_X);
      for (size_t c = gt; c < nchunk; c += NT) { const f32x4 a = xs[2 * c], b2 = xs[2 * c + 1]; v4u o; o.x = pk2(a.x, a.y); o.y = pk2(a.z, a.w); o.z = pk2(b2.x, b2.y); o.w = pk2(b2.z, b2.w); *(GAS v4u*)((GAS bf16*)(ws + WS_XB) + pg8::tl_off((int)(c >> 9), (int)(c & 511) * 8, DM)) = o;
                                               v4u h; h.x = pk2h(a.x, a.y); h.y = pk2h(a.z, a.w); h.z = pk2h(b2.x, b2.y); h.w = pk2h(b2.z, b2.w); xh[c] = h; } }
}
__device__ __forceinline__ void ln_phase(Frame& F, const bf16* __restrict__ Y, const float* __restrict__ gam, const float* __restrict__ bet, float* __restrict__ XO, bf16* __restrict__ XBO, float* __restrict__ ST, int mbeg, int mend, int mstep) {
    int lane_ = (int)(threadIdx.x & 63u); asm volatile("" : "+v"(lane_)); const int lane = lane_;
    LAS f32x4* GL = (LAS f32x4*)(F.lds + RING_OFF); LAS f32x4* BL = GL + 1024;
    { int t_ = (int)threadIdx.x; asm volatile("" : "+v"(t_));
      for (int s = t_; s < 1024; s += NWAVES * 64) { const int d = (2 * (s >> 7) + (s & 1)) * 64 + ((s & 127) >> 1); GL[d] = ((const GAS f32x4*)gam)[s]; BL[d] = ((const GAS f32x4*)bet)[s]; } }
    __syncthreads();
    for (int m = mbeg; m < mend; m += mstep) {
        asm volatile("" ::: "memory");
        const GAS v4u* yr = (const GAS v4u*)(Y + (size_t)m * DM) + lane;
        v4u raw[8];
#pragma unroll
        for (int j = 0; j < 8; ++j) raw[j] = __builtin_nontemporal_load(yr + 64 * j);
        float v[8][8]; float s = 0.f;
#pragma unroll
        for (int j = 0; j < 8; ++j) { v[j][0] = h2f(raw[j].x & 0xffffu); v[j][1] = h2f(raw[j].x >> 16); v[j][2] = h2f(raw[j].y & 0xffffu); v[j][3] = h2f(raw[j].y >> 16);
            v[j][4] = h2f(raw[j].z & 0xffffu); v[j][5] = h2f(raw[j].z >> 16); v[j][6] = h2f(raw[j].w & 0xffffu); v[j][7] = h2f(raw[j].w >> 16);
            s += ((v[j][0] + v[j][1]) + (v[j][2] + v[j][3])) + ((v[j][4] + v[j][5]) + (v[j][6] + v[j][7])); }
        const float mean = wave_sum(s) * (1.f / DM); float s2 = 0.f;
#pragma unroll
        for (int j = 0; j < 8; ++j)
#pragma unroll
            for (int e = 0; e < 8; ++e) { v[j][e] -= mean; s2 += v[j][e] * v[j][e]; }
        const float rstd = 1.f / sqrtf(wave_sum(s2) * (1.f / DM) + LN_EPS);
        if (ST && lane == 0) *(GAS f32x2*)(ST + 2 * (size_t)m) = (f32x2){mean, rstd};
#pragma unroll
        for (int j = 0; j < 8; ++j) { const f32x4 g0 = GL[(2 * j) * 64 + lane], g1 = GL[(2 * j + 1) * 64 + lane], b0 = BL[(2 * j) * 64 + lane], b1 = BL[(2 * j + 1) * 64 + lane];
            const f32x4 o0 = (f32x4){v[j][0], v[j][1], v[j][2], v[j][3]} * rstd * g0 + b0, o1 = (f32x4){v[j][4], v[j][5], v[j][6], v[j][7]} * rstd * g1 + b1;
            if (XBO) { v4u w; w.x = pk2(o0.x, o0.y); w.y = pk2(o0.z, o0.w); w.z = pk2(o1.x, o1.y); w.w = pk2(o1.z, o1.w); *(GAS v4u*)(XBO + pg8::tl_off(m, 512 * j + 8 * lane, DM)) = w;
                       }
            else { GAS f32x4* xo = (GAS f32x4*)(XO + (size_t)m * DM) + 2 * lane + 128 * j; xo[0] = o0; xo[1] = o1; } }
    }
}
__device__ __forceinline__ void conv_phase(Frame& F, const bf16* __restrict__ U, const bf16* __restrict__ BG, const float* __restrict__ cw, bf16* __restrict__ V2, int jbeg, int jend, int jstep) {
    constexpr int NSEG = M / 32, NJOB = NSEG * 8;
    int lane_ = (int)(threadIdx.x & 63u); asm volatile("" : "+v"(lane_)); const int lane = lane_;
    for (int job = jbeg; job < jend; job += jstep) {
        const int cg = job & 7, seg = job >> 3, c0 = cg * 512 + lane * 8, r0 = seg * 32;
        float w0[8], w1[8], w2[8];
#pragma unroll
        for (int e = 0; e < 8; ++e) { w0[e] = cw[c0 + e]; w1[e] = cw[DM + c0 + e]; w2[e] = cw[2 * DM + c0 + e]; }
        float u1[8], u2[8];
        if ((r0 % SEQ) == 0) {
#pragma unroll
            for (int e = 0; e < 8; ++e) { u1[e] = 0.f; u2[e] = 0.f; }
        } else {
            const v4u a = *(const v4u*)(U + (size_t)(r0 - 1) * DM + c0), b2 = *(const v4u*)(U + (size_t)(r0 - 2) * DM + c0);
            u1[0] = bf2f(a.x & 0xffffu); u1[1] = bf2f(a.x >> 16); u1[2] = bf2f(a.y & 0xffffu); u1[3] = bf2f(a.y >> 16); u1[4] = bf2f(a.z & 0xffffu); u1[5] = bf2f(a.z >> 16); u1[6] = bf2f(a.w & 0xffffu); u1[7] = bf2f(a.w >> 16);
            u2[0] = bf2f(b2.x & 0xffffu); u2[1] = bf2f(b2.x >> 16); u2[2] = bf2f(b2.y & 0xffffu); u2[3] = bf2f(b2.y >> 16); u2[4] = bf2f(b2.z & 0xffffu); u2[5] = bf2f(b2.z >> 16); u2[6] = bf2f(b2.w & 0xffffu); u2[7] = bf2f(b2.w >> 16);
        }
#pragma unroll 4
        for (int t = 0; t < 32; ++t) {
            const v4u a = __builtin_nontemporal_load((const v4u*)(U + (size_t)(r0 + t) * DM + c0)), g4 = __builtin_nontemporal_load((const v4u*)(BG + (size_t)(r0 + t) * DM + c0));
            float u0[8], bg[8];
            u0[0] = bf2f(a.x & 0xffffu); u0[1] = bf2f(a.x >> 16); u0[2] = bf2f(a.y & 0xffffu); u0[3] = bf2f(a.y >> 16); u0[4] = bf2f(a.z & 0xffffu); u0[5] = bf2f(a.z >> 16); u0[6] = bf2f(a.w & 0xffffu); u0[7] = bf2f(a.w >> 16);
            bg[0] = bf2f(g4.x & 0xffffu); bg[1] = bf2f(g4.x >> 16); bg[2] = bf2f(g4.y & 0xffffu); bg[3] = bf2f(g4.y >> 16); bg[4] = bf2f(g4.z & 0xffffu); bg[5] = bf2f(g4.z >> 16); bg[6] = bf2f(g4.w & 0xffffu); bg[7] = bf2f(g4.w >> 16);
            float o[8];
#pragma unroll
            for (int e = 0; e < 8; ++e) { o[e] = bg[e] * (w0[e] * u2[e] + w1[e] * u1[e] + w2[e] * u0[e]); u2[e] = u1[e]; u1[e] = u0[e]; }
            v4u w; w.x = pk2(o[0], o[1]); w.y = pk2(o[2], o[3]); w.z = pk2(o[4], o[5]); w.w = pk2(o[6], o[7]);
            *(v4u*)(V2 + pg8::tl_off(r0 + t, c0, DM)) = w;
        }
    }
}

struct Args { const float* in[13]; float* out; unsigned char* ws; int ph_lo, ph_hi, use_bar, pad; };
__global__ void __launch_bounds__(NWAVES * 64, 2) mk_fwd(Args args) {
    extern __shared__ __attribute__((aligned(16))) unsigned char lds[];
    Frame F;
    F.lds = (LAS unsigned char*)lds;
    F.MISC = (volatile LAS unsigned*)(F.lds + MISC_OFF);
    F.tid = threadIdx.x; F.wave = __builtin_amdgcn_readfirstlane(F.tid >> 6);
    F.G = gridDim.x; { const int bx = blockIdx.x; F.vcu = (F.G % 8 == 0) ? (bx % 8) * (F.G / 8) + bx / 8 : bx; }
    unsigned char* ws = args.ws;
    F.ctl = (gu32*)(ws + WS_CTL);
    Ptrs P;
    P.x = args.in[0]; P.attn_w_in = args.in[1]; P.attn_sinks = args.in[2]; P.attn_w_out = args.in[3]; P.conv_w_in = args.in[4]; P.conv_w = args.in[5]; P.conv_w_out = args.in[6];
    P.ln_mix_g = args.in[7]; P.ln_mix_b = args.in[8]; P.ffn_w_gate_up = args.in[9]; P.ffn_w_down = args.in[10]; P.ln_ffn_g = args.in[11]; P.ln_ffn_b = args.in[12]; P.out = args.out; P.ws = ws;
    for (int u = F.tid; u < (LDS_BYTES - LDSCTL_OFF) / 4; u += NWAVES * 64) ((LAS unsigned*)(F.lds + LDSCTL_OFF))[u] = 0u;
    __syncthreads();
    XcdBarrier bar; bar.bar = (unsigned*)(F.ctl + CW_BAR); bar.x = 0; bar.st = nullptr; bar.rank = 0u;
    if (args.use_bar) { bar = xcd_barrier_post((unsigned*)(F.ctl + CW_BAR), F.MISC + 8); if (F.tid == 0) { F.MISC[10] = bar.rank; F.MISC[11] = bar.x; } }
    bool pl = false;
    int cidx = (int)blockIdx.x;
#if DEV_MODE
    const int lo = args.ph_lo, hi = args.ph_hi;
#else
    constexpr int lo = 0, hi = NPHASE;
#endif
#define IN(k) (lo <= (k) && (k) < hi)
#define SEAM(k) do { if (IN(k) && IN((k) + 1)) xcd_barrier(bar); } while (0)
#define GSEAM(k) do { if (IN(k) && IN((k) + 1)) { if (pl) group_barrier(F, (k) - 3, pmg); else xcd_barrier(bar); } } while (0)
#define PHASE_BEGIN(k) if (IN(k)) {
#define PHASE_END }

    PHASE_BEGIN(0) p0_prologue(F, P); PHASE_END
    SEAM(0);
    if (args.use_bar && IN(0) && IN(1)) {
        if (F.tid == 0) { bool ok = (F.G % 8) == 0;
            for (unsigned j = 0; j < 16; ++j) { const unsigned c = xb_ld(&bar.bar[XB_XCNT(j)]); ok = ok && (c == (j < 8u ? (unsigned)F.G / 8u : 0u)); }
            F.MISC[12] = ok ? 1u : 0u; }
        __syncthreads();
        if (F.MISC[12] != 0u) cidx = (int)(F.MISC[10] * 8u + F.MISC[11]);
        cidx = __builtin_amdgcn_readfirstlane(cidx);
        if (F.G % 8 == 0) F.vcu = (cidx % 8) * (F.G / 8) + cidx / 8;
        pl = (F.MISC[12] != 0u) && F.G == 256;
    }
    const int pmg = 4 * (cidx & 7) + ((cidx >> 3) & 3), rankg = cidx >> 5;
    const int gwv = F.vcu * NWAVES + F.wave, NGWV = F.G * NWAVES;
#pragma unroll 1
    for (int layer = 0; layer < 2; ++layer) {
        const int pb = 1 + 7 * layer;
        { GAS unsigned char* wl = (GAS unsigned char*)args.ws; asm volatile("" : "+s"(wl)); ws = (unsigned char*)wl; }
        bf16* const XB = (bf16*)(ws + WS_XB); bf16* const QKb = (bf16*)(ws + WS_QK); bf16* const VTb = (bf16*)(ws + WS_VT); bf16* const Ob = (bf16*)(ws + WS_O);
        bf16* const Yh = (bf16*)(ws + WS_Y); bf16* const XH = (bf16*)(ws + WS_X); float* const STf = (float*)(ws + WS_ST); bf16* const Hb = (bf16*)(ws + WS_H); bf16* const Ub = (bf16*)(ws + WS_U); bf16* const BGb = (bf16*)(ws + WS_BG);
        if (layer == 0) {
            PHASE_BEGIN(1) {
                { pg8::Gemm g{XB, (const bf16*)(ws + WS_WQKV), M, NQK, DM}; pg8::StaticOrder S; S.init(M, NQK, F.G, cidx);
                  pg8::EpiBf16 E{QKb, NQK};
                  pg8::gemm_phase<pg8::EpiBf16, pg8::StaticOrder, true, true>(F.lds + RING_OFF, g, S, E); }
                { pg8::Gemm g{(const bf16*)(ws + WS_WV), XB, NKV, M, DM}; pg8::StaticOrder S; S.init(NKV, M, F.G, (cidx + F.G / 2) % F.G);
                  pg8::EpiBf16 E{VTb, M};
                  pg8::gemm_phase<pg8::EpiBf16, pg8::StaticOrder, true, true>(F.lds + RING_OFF, g, S, E); }
            } PHASE_END
            SEAM(1);
            PHASE_BEGIN(2) {
                for (int u = F.vcu; u < BATCH * NKVH * (SEQ / 128); u += F.G)
                    att::attn_unit(F.lds + RING_OFF, QKb, VTb, Ob, P.attn_sinks, u >> 8, (u >> 5) & 7, u & 31);
            } PHASE_END
            SEAM(2);
        } else {
            PHASE_BEGIN(8) {
                pg8::Gemm g{XB, (const bf16*)(ws + WS_WCI), M, NCI, DM}; pg8::StaticOrder S; S.init(M, NCI, F.G, cidx);
                pg8::EpiConvIn E{Ub, BGb, DM, DM / 128};
                pg8::gemm_phase<pg8::EpiConvIn, pg8::StaticOrder, true, true>(F.lds + RING_OFF, g, S, E);
            } PHASE_END
            SEAM(8);
            PHASE_BEGIN(9) { if (pl) { const int jb = (8 * pmg + rankg) * 8 + F.wave; conv_phase(F, Ub, BGb, P.conv_w, Ob, jb, jb + 1, 1); } else conv_phase(F, Ub, BGb, P.conv_w, Ob, gwv, (M / 32) * 8, NGWV); } PHASE_END
            GSEAM(9);
        }
        PHASE_BEGIN(pb + 2) {
            pg8::StaticOrder S; S.init(M, DM, F.G, cidx);
            if (layer == 0) { pg8::Gemm g{Ob, (const bf16*)(ws + WS_WO), M, DM, DM}; pg8::EpiResF16 E{XH, Yh, DM, ALPHA};
                pg8::gemm_phase<pg8::EpiResF16, pg8::StaticOrder, true, true>(F.lds + RING_OFF, g, S, E); }
            else { pg8::Gemm g{Ob, (const bf16*)(ws + WS_WCO), M, DM, DM}; pg8::EpiResLN E{Yh, DM, ALPHA, STf, P.ln_ffn_g, P.ln_ffn_b};
                pg8::gemm_phase<pg8::EpiResLN, pg8::StaticOrder, true, true>(F.lds + RING_OFF, g, S, E); }
        } PHASE_END
        GSEAM(pb + 2);
        PHASE_BEGIN(pb + 3) { const int mb = pl ? 256 * pmg + 32 * rankg + F.wave : gwv; ln_phase(F, Yh, P.ln_mix_g + layer * DM, P.ln_mix_b + layer * DM, (float*)nullptr, XB, STf, mb, pl ? 256 * pmg + 32 * rankg + 32 : M, pl ? NWAVES : NGWV); } PHASE_END
        GSEAM(pb + 3);
        PHASE_BEGIN(pb + 4) {
            pg8::Gemm g{XB, (const bf16*)(ws + (layer ? WS_WGU1 : WS_WGU0)), M, NGU, DM}; pg8::StaticOrder S; S.init(M, NGU, F.G, cidx);
            pg8::EpiSwiGLU E{Hb, FFH};
            pg8::gemm_phase<pg8::EpiSwiGLU, pg8::StaticOrder, true, true>(F.lds + RING_OFF, g, S, E);
        } PHASE_END
        GSEAM(pb + 4);
        PHASE_BEGIN(pb + 5) {
            pg8::Gemm g{Hb, (const bf16*)(ws + (layer ? WS_WD1 : WS_WD0)), M, DM, FFH}; pg8::StaticOrder S; S.init(M, DM, F.G, cidx);
            pg8::EpiResLN E{Yh, DM, ALPHA, STf, P.ln_mix_g + layer * DM, P.ln_mix_b + layer * DM};
            pg8::gemm_phase<pg8::EpiResLN, pg8::StaticOrder, true, true>(F.lds + RING_OFF, g, S, E);
        } PHASE_END
        GSEAM(pb + 5);
        PHASE_BEGIN(pb + 6) { const int mb = pl ? 256 * pmg + 32 * rankg + F.wave : gwv; ln_phase(F, Yh, P.ln_ffn_g + layer * DM, P.ln_ffn_b + layer * DM, layer ? P.out : (float*)nullptr, layer ? (bf16*)nullptr : XB, layer ? (float*)nullptr : STf, mb, pl ? 256 * pmg + 32 * rankg + 32 : M, pl ? NWAVES : NGWV); } PHASE_END
        if (layer == 0) GSEAM(pb + 6);
    }
#undef GSEAM
#undef IN
#undef PHASE_BEGIN
#undef PHASE_END
#undef SEAM
}

#if DEV_MODE
__device__ __forceinline__ int crow16(int r, int hi) { return (r & 3) + 8 * (r >> 2) + 4 * hi; }
template <bool OUT_BF16> __global__ void __launch_bounds__(256) ref_gemm(const bf16* __restrict__ A, const bf16* __restrict__ Bt, void* __restrict__ C, int M_, int N_, int K_, int ldc) {
    __shared__ __attribute__((aligned(16))) bf16 As[128 * 40];
    __shared__ __attribute__((aligned(16))) bf16 Bs[128 * 40];
    const int tid = threadIdx.x, lane = tid & 63, w = tid >> 6, wm = w >> 1, wn = w & 1, r32 = lane & 31, hi = lane >> 5;
    const int bm = blockIdx.y * 128, bn = blockIdx.x * 128;
    f32x16 acc[2][2];
#pragma unroll
    for (int a = 0; a < 2; ++a)
#pragma unroll
        for (int b = 0; b < 2; ++b)
#pragma unroll
            for (int r = 0; r < 16; ++r) acc[a][b][r] = 0.f;
    for (int k0 = 0; k0 < K_; k0 += 32) {
#pragma unroll
        for (int i = 0; i < 2; ++i) { const int idx = tid + 256 * i, row = idx >> 2, ch = idx & 3;
            *(v4u*)&As[row * 40 + ch * 8] = *(const v4u*)&A[pg8::tl_off(bm + row, k0 + ch * 8, K_)];
            *(v4u*)&Bs[row * 40 + ch * 8] = *(const v4u*)&Bt[pg8::tl_off(bn + row, k0 + ch * 8, K_)]; }
        __syncthreads();
#pragma unroll
        for (int ks = 0; ks < 2; ++ks) {
            bf16x8 a[2], b[2];
#pragma unroll
            for (int i = 0; i < 2; ++i) { a[i] = *(const bf16x8*)&As[(wm * 64 + i * 32 + r32) * 40 + ks * 16 + hi * 8]; b[i] = *(const bf16x8*)&Bs[(wn * 64 + i * 32 + r32) * 40 + ks * 16 + hi * 8]; }
#pragma unroll
            for (int mi = 0; mi < 2; ++mi)
#pragma unroll
                for (int ni = 0; ni < 2; ++ni) acc[mi][ni] = MFMA32(a[mi], b[ni], acc[mi][ni]);
        }
        __syncthreads();
    }
#pragma unroll
    for (int mi = 0; mi < 2; ++mi)
#pragma unroll
        for (int ni = 0; ni < 2; ++ni)
#pragma unroll
            for (int r = 0; r < 16; ++r) { const size_t row = bm + wm * 64 + mi * 32 + crow16(r, hi), col = bn + wn * 64 + ni * 32 + r32;
                if (OUT_BF16) ((bf16*)C)[row * ldc + col] = (bf16)f2bf(acc[mi][ni][r]); else ((float*)C)[row * ldc + col] = acc[mi][ni][r]; }
}
__global__ void __launch_bounds__(256) ref_res(const float* __restrict__ C, const bf16* __restrict__ R, bf16* __restrict__ Y, float alpha, size_t n) {
    for (size_t i = (size_t)blockIdx.x * 256 + threadIdx.x; i < n; i += (size_t)gridDim.x * 256) Y[i] = (bf16)(pk2h(alpha * h2f(R[i]) + C[i], 0.f) & 0xffffu);
}
__global__ void __launch_bounds__(256) ref_res_ln(const float* __restrict__ C, bf16* __restrict__ Y, const float* __restrict__ ST, const float* __restrict__ G, const float* __restrict__ B, float alpha, size_t n) {
    for (size_t i = (size_t)blockIdx.x * 256 + threadIdx.x; i < n; i += (size_t)gridDim.x * 256) { const size_t m = i / DM; const int c = (int)(i % DM);
        const float x = (h2f(Y[i]) - ST[2 * m]) * ST[2 * m + 1] * G[c] + B[c]; Y[i] = (bf16)(pk2h(alpha * x + C[i], 0.f) & 0xffffu); }
}
__global__ void __launch_bounds__(256) ref_swiglu(const float* __restrict__ C, bf16* __restrict__ H) {
    const size_t n = (size_t)M * FFH;
    for (size_t i = (size_t)blockIdx.x * 256 + threadIdx.x; i < n; i += (size_t)gridDim.x * 256) { const size_t m = i / FFH; const int j = (int)(i % FFH), p = j >> 7, jj = j & 127;
        const float g = C[m * NGU + 256 * p + jj], u = C[m * NGU + 256 * p + 128 + jj]; H[i] = (bf16)f2bf(g / (1.0f + expf(-g)) * u); }
}
__global__ void __launch_bounds__(256) ref_convmul(const float* __restrict__ C, bf16* __restrict__ U, bf16* __restrict__ BG) {
    const size_t n = (size_t)M * DM;
    for (size_t i = (size_t)blockIdx.x * 256 + threadIdx.x; i < n; i += (size_t)gridDim.x * 256) { const size_t m = i / DM; const int c = (int)(i % DM), p = c >> 7, cc = c & 127;
        U[i] = (bf16)f2bf(C[m * NCI + 256 * p + cc] * C[m * NCI + 256 * p + 128 + cc]); BG[i] = (bf16)f2bf(C[m * NCI + 2 * DM + c]); }
}
__global__ void __launch_bounds__(256) ref_attn(const bf16* __restrict__ QK, const bf16* __restrict__ VT, const float* __restrict__ sinks, bf16* __restrict__ O) {
    const int lane = threadIdx.x & 63, gwv = blockIdx.x * 4 + (threadIdx.x >> 6); const int m = gwv >> 5, h = gwv & 31, b = m / SEQ, s = m % SEQ, g = h >> 2;
    const bf16* q = QK + (size_t)m * NQK + h * HD;
    const float q0 = bf2f(q[lane]), q1 = bf2f(q[64 + lane]);
    float sc[2]; bool ok[2]; int pos[2];
#pragma unroll
    for (int kk = 0; kk < 2; ++kk) { pos[kk] = s - 127 + lane + 64 * kk; ok[kk] = pos[kk] >= 0; const int pp = ok[kk] ? pos[kk] : 0;
        const bf16* kr = QK + (size_t)(b * SEQ + pp) * NQK + NQ + g * HD; float dot = 0.f;
        for (int d = 0; d < 64; ++d) dot += __shfl(q0, d) * bf2f(kr[d]);
        for (int d = 0; d < 64; ++d) dot += __shfl(q1, d) * bf2f(kr[64 + d]);
        sc[kk] = ok[kk] ? dot * 0.08838834764831845f : -INFINITY; }
    const float sink = sinks[h];
    float mx = fmaxf(sc[0], sc[1]);
#pragma unroll
    for (int o = 1; o < 64; o <<= 1) mx = fmaxf(mx, __shfl_xor(mx, o));
    mx = fmaxf(mx, sink);
    const float p0 = ok[0] ? expf(sc[0] - mx) : 0.f, p1 = ok[1] ? expf(sc[1] - mx) : 0.f;
    const float denom = wave_sum(p0 + p1) + expf(sink - mx);
    float o0 = 0.f, o1 = 0.f;
    const int pp0 = ok[0] ? pos[0] : 0, pp1 = ok[1] ? pos[1] : 0;
    for (int d = 0; d < 128; ++d) { const bf16* vr = VT + (size_t)(g * HD + d) * M + (size_t)b * SEQ;
        const float part = p0 * bf2f(vr[pp0]) + p1 * bf2f(vr[pp1]); const float tot = wave_sum(part);
        if (d < 64) { if (lane == d) o0 = tot; } else { if (lane == d - 64) o1 = tot; } }
    bf16* op = O + (size_t)m * NQ + h * HD; op[lane] = (bf16)f2bf(o0 / denom); op[64 + lane] = (bf16)f2bf(o1 / denom);
}
#endif

extern "C" void kernel_launch(void* const* d_in, const int* in_sizes, int n_in, void* d_out, int out_size, void* d_ws, size_t ws_size, hipStream_t stream) {
    static int grid = 0;
    if (grid == 0) {
        if (n_in != 13 || in_sizes[0] != M * DM || out_size != M * DM || ws_size < WS_END) { fprintf(stderr, "kernel_launch: shape/workspace mismatch (n_in %d, in0 %d, out %d, ws %zu < %zu); nothing launched\n", n_in, n_in > 0 ? in_sizes[0] : -1, out_size, ws_size, (size_t)WS_END); grid = -1; return; }
        int dev = 0, cus = 0, per_cu = 0;
        if (hipGetDevice(&dev) != hipSuccess || hipDeviceGetAttribute(&cus, hipDeviceAttributeMultiprocessorCount, dev) != hipSuccess) { fprintf(stderr, "kernel_launch: device query failed\n"); grid = -1; return; }
        if (hipFuncSetAttribute((const void*)mk_fwd, hipFuncAttributeMaxDynamicSharedMemorySize, LDS_BYTES) != hipSuccess) { fprintf(stderr, "kernel_launch: hipFuncSetAttribute failed\n"); grid = -1; return; }
        if (hipOccupancyMaxActiveBlocksPerMultiprocessor(&per_cu, (const void*)mk_fwd, NWAVES * 64, LDS_BYTES) != hipSuccess || per_cu < 1) fprintf(stderr, "kernel_launch: note: occupancy query reports %d workgroups per CU\n", per_cu);
        (void)hipGetLastError();
        grid = cus;
    }
    if (grid < 0) return;
    if (hipMemsetAsync((char*)d_ws + WS_CTL, 0, CTL_ZERO_BYTES, stream) != hipSuccess) { fprintf(stderr, "kernel_launch: memset failed\n"); return; }
    Args a{};
    for (int i = 0; i < 13; ++i) a.in[i] = (const float*)d_in[i];
    a.out = (float*)d_out; a.ws = (unsigned char*)d_ws;
#if !DEV_MODE
    a.ph_lo = 0; a.ph_hi = NPHASE; a.use_bar = 1;
    hipLaunchKernelGGL(mk_fwd, dim3(grid), dim3(NWAVES * 64), LDS_BYTES, stream, a);
    { const hipError_t le = hipPeekAtLastError(); if (le != hipSuccess) fprintf(stderr, "kernel_launch: launch failed: %s\n", hipGetErrorName(le)); }
#else
    unsigned char* ws = (unsigned char*)d_ws;
    bf16* XB = (bf16*)(ws + WS_XB); bf16* QKb = (bf16*)(ws + WS_QK); bf16* VTb = (bf16*)(ws + WS_VT); bf16* Ob = (bf16*)(ws + WS_O); bf16* Yh = (bf16*)(ws + WS_Y); bf16* XH = (bf16*)(ws + WS_X); float* STf = (float*)(ws + WS_ST);
    bf16* Hb = (bf16*)(ws + WS_H); bf16* Ub = (bf16*)(ws + WS_U); bf16* BGb = (bf16*)(ws + WS_BG); float* Cf = (float*)(ws + WS_C);
    for (int p = 0; p < NPHASE; ++p) {
        const int layer = p >= 8 ? 1 : 0, q = p == 0 ? -1 : (p - 1) % 7;
        const bool shared = (p == 0) || q == 3 || q == 6 || p == 9;
        if (shared || ((FASTMASK >> p) & 1u)) { a.ph_lo = p; a.ph_hi = p + 1; a.use_bar = 0; hipLaunchKernelGGL(mk_fwd, dim3(grid), dim3(NWAVES * 64), LDS_BYTES, stream, a); continue; }
        if (p == 1) { hipLaunchKernelGGL(ref_gemm<true>, dim3(NQK / 128, M / 128), dim3(256), 0, stream, XB, (const bf16*)(ws + WS_WQKV), (void*)QKb, M, NQK, DM, NQK);
                      hipLaunchKernelGGL(ref_gemm<true>, dim3(M / 128, NKV / 128), dim3(256), 0, stream, (const bf16*)(ws + WS_WV), XB, (void*)VTb, NKV, M, DM, M); }
        else if (p == 2) hipLaunchKernelGGL(ref_attn, dim3(M * NHEAD / 4), dim3(256), 0, stream, QKb, VTb, (const float*)d_in[2], Ob);
        else if (p == 8) { hipLaunchKernelGGL(ref_gemm<false>, dim3(NCI / 128, M / 128), dim3(256), 0, stream, XB, (const bf16*)(ws + WS_WCI), (void*)Cf, M, NCI, DM, NCI);
                           hipLaunchKernelGGL(ref_convmul, dim3(4096), dim3(256), 0, stream, Cf, Ub, BGb); }
        else if (q == 2) { hipLaunchKernelGGL(ref_gemm<false>, dim3(DM / 128, M / 128), dim3(256), 0, stream, Ob, (const bf16*)(ws + (layer ? WS_WCO : WS_WO)), (void*)Cf, M, DM, DM, DM);
                           if (layer == 0) hipLaunchKernelGGL(ref_res, dim3(4096), dim3(256), 0, stream, Cf, (const bf16*)XH, Yh, ALPHA, (size_t)M * DM);
                           else hipLaunchKernelGGL(ref_res_ln, dim3(4096), dim3(256), 0, stream, Cf, Yh, (const float*)STf, (const float*)d_in[11], (const float*)d_in[12], ALPHA, (size_t)M * DM); }
        else if (q == 4) { hipLaunchKernelGGL(ref_gemm<false>, dim3(NGU / 128, M / 128), dim3(256), 0, stream, XB, (const bf16*)(ws + (layer ? WS_WGU1 : WS_WGU0)), (void*)Cf, M, NGU, DM, NGU);
                           hipLaunchKernelGGL(ref_swiglu, dim3(8192), dim3(256), 0, stream, Cf, Hb); }
        else if (q == 5) { hipLaunchKernelGGL(ref_gemm<false>, dim3(DM / 128, M / 128), dim3(256), 0, stream, Hb, (const bf16*)(ws + (layer ? WS_WD1 : WS_WD0)), (void*)Cf, M, DM, FFH, DM);
                           hipLaunchKernelGGL(ref_res_ln, dim3(4096), dim3(256), 0, stream, Cf, Yh, (const float*)STf, (const float*)d_in[7] + layer * DM, (const float*)d_in[8] + layer * DM, ALPHA, (size_t)M * DM); }
    }
    { const hipError_t le = hipPeekAtLastError(); if (le != hipSuccess) fprintf(stderr, "kernel_launch: a launch failed: %s\n", hipGetErrorName(le)); }
#endif
}
```

```cpp
#include <hip/hip_runtime.h>
#include <cstdio>
#include <cstdint>
#include <cmath>

#ifndef DEV_MODE
#define DEV_MODE 0
#endif
#ifndef FASTMASK
#define FASTMASK 0x7fffu
#endif

namespace pg8 {
#define PG8_LAS __attribute__((address_space(3)))
typedef unsigned short bf16_t;
typedef short bf16x8 __attribute__((ext_vector_type(8)));
typedef float f32x4 __attribute__((ext_vector_type(4)));
typedef unsigned u32x4 __attribute__((ext_vector_type(4)));
constexpr int BM = 256, BK = 64, HALF = 128, HTB = HALF * BK * 2  , STAGE_BYTES = 8 * HTB, NXCD = 8, WGM = 4;

__host__ __device__ __forceinline__ int lds_byte(int r, int c) { const int st = (r >> 4) * 2 + (c >> 5), rr = r & 15, cc = c & 31, ob = rr * 64 + cc * 2; return st * 1024 + (ob ^ (((ob >> 9) & 1) << 5)); }
__host__ __device__ __forceinline__ void stage_rc(int b, int& R, int& C) { const int st = b / 1024, sb = b % 1024, swz = sb ^ (((sb >> 9) & 1) << 5); R = (st >> 1) * 16 + swz / 64; C = (st & 1) * 32 + (swz % 64) / 2; }
__host__ __device__ __forceinline__ int perm32(int rho) { const int n = rho >> 4, i = rho & 15; return 8 * (i >> 2) + 4 * n + (i & 3); }

__host__ __device__ __forceinline__ size_t tl_off(int row, int k, int K) { return ((size_t)(row >> 8) * (size_t)(K >> 6) + (size_t)(k >> 6)) * 16384 + (size_t)(((row & 255) << 6) + (k & 63)); }
struct Unit { int pm, pn; };
struct Gemm { const bf16_t* A; const bf16_t* Bt; int M, N, K; };

struct StaticOrder {
    int nM, nN, nwg, G, c, nr;
    __host__ __device__ void init(int M, int N, int G_, int c_) { nM = M / BM; nN = N / BM; nwg = nM * nN; G = G_; c = c_; nr = 0; }
    __host__ __device__ void init_panel(int ncol, int pm_, int rk, int nr_) { nM = pm_; nN = ncol; nwg = 0; G = 0; c = rk; nr = nr_; }
    __host__ __device__ bool next(int i, Unit& u) const {
        if (nr) { u.pm = nM; u.pn = c + nr * i; return u.pn < nN; }
        const long L = (long)i * G + c; if (L >= nwg) return false;
        int wgid = (int)L; { const int q = nwg / NXCD, r = nwg % NXCD, xcd = wgid % NXCD, off = wgid / NXCD; wgid = (xcd < r ? xcd * (q + 1) : r * (q + 1) + (xcd - r) * q) + off; }
        const int nig = WGM * nN, gid = wgid / nig, fm = gid * WGM, gsz = (nM - fm) < WGM ? (nM - fm) : WGM;
        u.pm = fm + ((wgid % nig) % gsz); u.pn = (wgid % nig) / gsz; return true;
    }
    __device__ __forceinline__ void a_ready(const Unit&) const {}
    __device__ __forceinline__ void done(const Unit&) const {}
};

__device__ __forceinline__ unsigned cvt_pk_bf16(float lo, float hi) { unsigned r; asm volatile("v_cvt_pk_bf16_f32 %0, %1, %2" : "=v"(r) : "v"(lo), "v"(hi)); return r; }
typedef unsigned u32x2 __attribute__((ext_vector_type(2)));
typedef float f32x2 __attribute__((ext_vector_type(2)));
constexpr float LOG2E_F = 1.4426950408889634f;
__device__ __forceinline__ float silu_f(float g) { return g * __builtin_amdgcn_rcpf(1.0f + __builtin_amdgcn_exp2f(-g * LOG2E_F)); }

struct EpiBf16 {
    static constexpr bool PERM = true, AFTER_DRAIN = false;
    bf16_t* O; int ldc;
    __device__ __forceinline__ void operator()(const f32x4 (&acc)[2][2][4][2], const Unit& u, int wr, int wc, int fr, int fq) const {
        const int row0 = u.pm * BM + wr * 64 + fr, col0 = u.pn * BM + wc * 32 + 8 * fq;
#pragma unroll
        for (int ai = 0; ai < 2; ++ai)
#pragma unroll
            for (int m = 0; m < 4; ++m) { bf16_t* rowp = O + (size_t)(row0 + ai * HALF + m * 16) * ldc + col0;
#pragma unroll
                for (int bj = 0; bj < 2; ++bj) { const f32x4 v0 = acc[ai][bj][m][0], v1 = acc[ai][bj][m][1];
                    u32x4 w; w.x = cvt_pk_bf16(v0[0], v0[1]); w.y = cvt_pk_bf16(v0[2], v0[3]); w.z = cvt_pk_bf16(v1[0], v1[1]); w.w = cvt_pk_bf16(v1[2], v1[3]);
                    *(u32x4*)(rowp + bj * HALF) = w; } }
    }
};
struct EpiSwiGLU {
    static constexpr bool PERM = true, AFTER_DRAIN = false;
    bf16_t* H; int ldh;
    __device__ __forceinline__ void operator()(const f32x4 (&acc)[2][2][4][2], const Unit& u, int wr, int wc, int fr, int fq) const {
        const int row0 = u.pm * BM + wr * 64 + fr, col0 = u.pn * HALF + wc * 32 + 8 * fq;
#pragma unroll
        for (int ai = 0; ai < 2; ++ai)
#pragma unroll
            for (int m = 0; m < 4; ++m) { bf16_t* rowp = H + tl_off(row0 + ai * HALF + m * 16, col0, ldh);
                const f32x4 g0 = acc[ai][0][m][0], g1 = acc[ai][0][m][1], u0 = acc[ai][1][m][0], u1 = acc[ai][1][m][1];
                u32x4 w;
                w.x = cvt_pk_bf16(silu_f(g0[0]) * u0[0], silu_f(g0[1]) * u0[1]); w.y = cvt_pk_bf16(silu_f(g0[2]) * u0[2], silu_f(g0[3]) * u0[3]);
                w.z = cvt_pk_bf16(silu_f(g1[0]) * u1[0], silu_f(g1[1]) * u1[1]); w.w = cvt_pk_bf16(silu_f(g1[2]) * u1[2], silu_f(g1[3]) * u1[3]);
                __builtin_nontemporal_store(w, (u32x4*)rowp); }
    }
};
struct EpiConvIn {
    static constexpr bool PERM = true, AFTER_DRAIN = false;
    bf16_t* U; bf16_t* BG; int ld; int npair;
    __device__ __forceinline__ void operator()(const f32x4 (&acc)[2][2][4][2], const Unit& u, int wr, int wc, int fr, int fq) const {
        const int row0 = u.pm * BM + wr * 64 + fr;
        if (u.pn < npair) {
            const int col0 = u.pn * HALF + wc * 32 + 8 * fq;
#pragma unroll
            for (int ai = 0; ai < 2; ++ai)
#pragma unroll
                for (int m = 0; m < 4; ++m) { bf16_t* rowp = U + (size_t)(row0 + ai * HALF + m * 16) * ld + col0;
                    const f32x4 v0 = acc[ai][0][m][0] * acc[ai][1][m][0], v1 = acc[ai][0][m][1] * acc[ai][1][m][1];
                    u32x4 w; w.x = cvt_pk_bf16(v0[0], v0[1]); w.y = cvt_pk_bf16(v0[2], v0[3]); w.z = cvt_pk_bf16(v1[0], v1[1]); w.w = cvt_pk_bf16(v1[2], v1[3]);
                    *(u32x4*)rowp = w; }
        } else {
            const int col0 = (u.pn - npair) * BM + wc * 32 + 8 * fq;
#pragma unroll
            for (int ai = 0; ai < 2; ++ai)
#pragma unroll
                for (int m = 0; m < 4; ++m) { bf16_t* rowp = BG + (size_t)(row0 + ai * HALF + m * 16) * ld + col0;
#pragma unroll
                    for (int bj = 0; bj < 2; ++bj) { const f32x4 v0 = acc[ai][bj][m][0], v1 = acc[ai][bj][m][1];
                        u32x4 w; w.x = cvt_pk_bf16(v0[0], v0[1]); w.y = cvt_pk_bf16(v0[2], v0[3]); w.z = cvt_pk_bf16(v1[0], v1[1]); w.w = cvt_pk_bf16(v1[2], v1[3]);
                        *(u32x4*)(rowp + bj * HALF) = w; } }
        }
    }
};
typedef _Float16 f16x8 __attribute__((ext_vector_type(8)));
__device__ __forceinline__ unsigned cvt_pk_f16(float lo, float hi) { unsigned r; asm volatile("v_cvt_pk_f16_f32 %0, %1, %2" : "=v"(r) : "v"(lo), "v"(hi)); return r; }
struct EpiResF16 {
    static constexpr bool PERM = true, AFTER_DRAIN = false;
    const bf16_t* R; bf16_t* Y; int ldc; float alpha;
    __device__ __forceinline__ void operator()(const f32x4 (&acc)[2][2][4][2], const Unit& u, int wr, int wc, int fr, int fq) const {
        const int row0 = u.pm * BM + wr * 64 + fr, col0 = u.pn * BM + wc * 32 + 8 * fq;
#pragma unroll
        for (int ai = 0; ai < 2; ++ai) {
            u32x4 rv[4][2];
#pragma unroll
            for (int m = 0; m < 4; ++m)
#pragma unroll
                for (int bj = 0; bj < 2; ++bj) rv[m][bj] = *(const u32x4*)(R + (size_t)(row0 + ai * HALF + m * 16) * ldc + col0 + bj * HALF);
#pragma unroll
            for (int m = 0; m < 4; ++m)
#pragma unroll
                for (int bj = 0; bj < 2; ++bj) { const f16x8 hr = __builtin_bit_cast(f16x8, rv[m][bj]);
                    const f32x4 a0 = acc[ai][bj][m][0], a1 = acc[ai][bj][m][1]; u32x4 w;
                    w.x = cvt_pk_f16((float)hr[0] * alpha + a0[0], (float)hr[1] * alpha + a0[1]);
                    w.y = cvt_pk_f16((float)hr[2] * alpha + a0[2], (float)hr[3] * alpha + a0[3]);
                    w.z = cvt_pk_f16((float)hr[4] * alpha + a1[0], (float)hr[5] * alpha + a1[1]);
                    w.w = cvt_pk_f16((float)hr[6] * alpha + a1[2], (float)hr[7] * alpha + a1[3]);
                    *(u32x4*)(Y + (size_t)(row0 + ai * HALF + m * 16) * ldc + col0 + bj * HALF) = w; }
            asm volatile("" ::: "memory"); }
    }
};

struct EpiResLN {
    static constexpr bool PERM = true, AFTER_DRAIN = false;
    bf16_t* Y; int ldc; float alpha; const float* ST; const float* G; const float* B;
    __device__ __forceinline__ void operator()(const f32x4 (&acc)[2][2][4][2], const Unit& u, int wr, int wc, int fr, int fq) const {
        asm volatile("" ::: "memory");
        int fr_ = fr, fq_ = fq; asm volatile("" : "+v"(fr_), "+v"(fq_));
        const int row0 = u.pm * BM + wr * 64 + fr_, col0 = u.pn * BM + wc * 32 + 8 * fq_;
        typedef __attribute__((address_space(1))) const float gcf; typedef __attribute__((address_space(1))) const f32x4 gcf4; typedef __attribute__((address_space(1))) const f32x2 gcf2;
        gcf* Gg = (gcf*)G; gcf* Bg = (gcf*)B; gcf* STg = (gcf*)ST;
        f32x4 ga[2][2], ba[2][2];
#pragma unroll
        for (int bj = 0; bj < 2; ++bj)
#pragma unroll
            for (int n = 0; n < 2; ++n) { ga[bj][n] = *(gcf4*)(Gg + col0 + bj * HALF + 4 * n) * alpha; ba[bj][n] = *(gcf4*)(Bg + col0 + bj * HALF + 4 * n) * alpha; }
#pragma unroll
        for (int ai = 0; ai < 2; ++ai) {
            u32x4 rv[4][2]; f32x2 st[4];
#pragma unroll
            for (int m = 0; m < 4; ++m) { st[m] = *(gcf2*)(STg + 2 * (size_t)(row0 + ai * HALF + m * 16));
#pragma unroll
                for (int bj = 0; bj < 2; ++bj) rv[m][bj] = *(const u32x4*)(Y + (size_t)(row0 + ai * HALF + m * 16) * ldc + col0 + bj * HALF); }
#pragma unroll
            for (int m = 0; m < 4; ++m)
#pragma unroll
                for (int bj = 0; bj < 2; ++bj) { const f16x8 hr = __builtin_bit_cast(f16x8, rv[m][bj]); const float mu = st[m].x, rs = st[m].y;
                    const f32x4 a0 = acc[ai][bj][m][0], a1 = acc[ai][bj][m][1], g0 = ga[bj][0], g1 = ga[bj][1], b0 = ba[bj][0], b1 = ba[bj][1]; u32x4 w;
                    w.x = cvt_pk_f16(((float)hr[0] - mu) * rs * g0[0] + (b0[0] + a0[0]), ((float)hr[1] - mu) * rs * g0[1] + (b0[1] + a0[1]));
                    w.y = cvt_pk_f16(((float)hr[2] - mu) * rs * g0[2] + (b0[2] + a0[2]), ((float)hr[3] - mu) * rs * g0[3] + (b0[3] + a0[3]));
                    w.z = cvt_pk_f16(((float)hr[4] - mu) * rs * g1[0] + (b1[0] + a1[0]), ((float)hr[5] - mu) * rs * g1[1] + (b1[1] + a1[1]));
                    w.w = cvt_pk_f16(((float)hr[6] - mu) * rs * g1[2] + (b1[2] + a1[2]), ((float)hr[7] - mu) * rs * g1[3] + (b1[3] + a1[3]));
                    *(u32x4*)(Y + (size_t)(row0 + ai * HALF + m * 16) * ldc + col0 + bj * HALF) = w; }
            asm volatile("" ::: "memory"); }
    }
};

template <class Epi, class Sched, bool ALIGN_EPI = false, bool SP2 = false>
__device__ __forceinline__ void gemm_phase(PG8_LAS unsigned char* lds, const Gemm g, const Sched& S, const Epi& E) {
    int tid_ = threadIdx.x; asm volatile("" : "+v"(tid_));
    const int tid = tid_, wid = __builtin_amdgcn_readfirstlane(tid >> 6), lane = tid & 63, wr = wid >> 2, wc = wid & 3, fr = lane & 15, fq = lane >> 4;
    const int K = g.K, nt = K / BK;
    unsigned voffA[2], voffB[2];
#pragma unroll
    for (int i = 0; i < 2; ++i) { int R, C; stage_rc(tid * 16 + i * 8192, R, C); const int Rb = Epi::PERM ? ((R & ~31) + perm32(R & 31)) : R;
        voffA[i] = (unsigned)(R * BK + C) * 2u; voffB[i] = (unsigned)(Rb * BK + C) * 2u; }
    const size_t kstep = (size_t)BM * BK * 2;
    const size_t hstep = (size_t)HALF * BK * 2;
    const size_t tstep = (size_t)BM * K * 2;
    const unsigned ldsw = (unsigned)wid * 1024u;
    const int aoff = lds_byte(wr * 64 + fr, fq * 8), boff = lds_byte(wc * 32 + fr, fq * 8);
#define PG8_SA(b, h) (((b) * 2 + (h)) * HTB)
#define PG8_SB(b, h) ((4 + (b) * 2 + (h)) * HTB)
#define PG8_STAGE(bufoff, gbase, voff) do { _Pragma("unroll") for (int _i = 0; _i < 2; ++_i) \
        __builtin_amdgcn_global_load_lds((const unsigned*)((const char*)(gbase) + (voff)[_i]), (PG8_LAS unsigned*)(lds + (bufoff) + ldsw + _i * 8192), 16, 0, 0); } while (0)
#define PG8_LDA(dst, b, h) do { _Pragma("unroll") for (int m = 0; m < 4; ++m) _Pragma("unroll") for (int k = 0; k < 2; ++k) dst[m][k] = *(const PG8_LAS bf16x8*)(lds + PG8_SA(b, h) + aoff + m * 2048 + k * 1024); } while (0)
#define PG8_LDB(dst, b, h) do { _Pragma("unroll") for (int n = 0; n < 2; ++n) _Pragma("unroll") for (int k = 0; k < 2; ++k) dst[n][k] = *(const PG8_LAS bf16x8*)(lds + PG8_SB(b, h) + boff + n * 2048 + k * 1024); } while (0)
#define PG8_MMA(ai, bj, At, Bt) do { __builtin_amdgcn_s_setprio(1); _Pragma("unroll") for (int m = 0; m < 4; ++m) _Pragma("unroll") for (int n = 0; n < 2; ++n) _Pragma("unroll") for (int k = 0; k < 2; ++k) \
        acc[ai][bj][m][n] = __builtin_amdgcn_mfma_f32_16x16x32_bf16(Bt[n][k], At[m][k], acc[ai][bj][m][n], 0, 0, 0); __builtin_amdgcn_s_setprio(0); } while (0)
#define PG8_WAIT_V(n) asm volatile("s_waitcnt vmcnt(" #n ")" ::: "memory")
#define PG8_WAIT_L(n) asm volatile("s_waitcnt lgkmcnt(" #n ")" ::: "memory")
#define PG8_BAR __builtin_amdgcn_s_barrier()
#define PG8_SCHED __builtin_amdgcn_sched_barrier(0)
    Unit cur, nxt; int ui = 0;
    if (!S.next(0, cur)) return;
    f32x4 acc[2][2][4][2];
#pragma unroll
    for (int a = 0; a < 2; ++a)
#pragma unroll
        for (int b = 0; b < 2; ++b)
#pragma unroll
            for (int m = 0; m < 4; ++m)
#pragma unroll
                for (int n = 0; n < 2; ++n) acc[a][b][m][n] = (f32x4){0.f, 0.f, 0.f, 0.f};
    bf16x8 At[4][2], B0[2][2], B1[2][2];
    const char* cA = (const char*)g.A + (size_t)cur.pm * tstep; const char* cB = (const char*)g.Bt + (size_t)cur.pn * tstep;
    S.a_ready(cur);
    if constexpr (SP2) {
        PG8_STAGE(PG8_SB(0, 0), cB, voffB); PG8_STAGE(PG8_SB(0, 1), cB + hstep, voffB); PG8_STAGE(PG8_SA(0, 0), cA, voffA); PG8_STAGE(PG8_SA(0, 1), cA + hstep, voffA);
        if (wr == 1) PG8_BAR;
        PG8_WAIT_V(2); PG8_BAR;
        PG8_STAGE(PG8_SB(1, 0), cB + kstep, voffB); PG8_STAGE(PG8_SA(1, 0), cA + kstep, voffA); PG8_STAGE(PG8_SB(1, 1), cB + hstep + kstep, voffB);
        PG8_WAIT_V(6); PG8_BAR;
    } else {
        PG8_STAGE(PG8_SB(0, 0), cB, voffB); PG8_STAGE(PG8_SA(0, 0), cA, voffA); PG8_STAGE(PG8_SB(0, 1), cB + hstep, voffB); PG8_STAGE(PG8_SA(0, 1), cA + hstep, voffA);
        if (wr == 1) PG8_BAR;
        PG8_WAIT_V(4); PG8_BAR;
        PG8_STAGE(PG8_SB(1, 0), cB + kstep, voffB); PG8_STAGE(PG8_SA(1, 0), cA + kstep, voffA); PG8_STAGE(PG8_SB(1, 1), cB + hstep + kstep, voffB);
        PG8_WAIT_V(6); PG8_BAR;
    }
    for (;;) {
        const bool has_next = S.next(ui + 1, nxt);
        const char* nA = has_next ? (const char*)g.A + (size_t)nxt.pm * tstep : cA; const char* nB = has_next ? (const char*)g.Bt + (size_t)nxt.pn * tstep : cB;
        for (int t = 0; t < nt; t += 2) {
            const bool last = (t == nt - 2);
            const char* a1 = cA + (size_t)(t + 1) * kstep;
            const char* a2 = last ? nA : cA + (size_t)(t + 2) * kstep; const char* b2 = last ? nB : cB + (size_t)(t + 2) * kstep;
            const char* a3 = a2 + kstep; const char* b3 = b2 + kstep;
            if (last && has_next) S.a_ready(nxt);
            if constexpr (SP2) {
            PG8_LDB(B0, 0, 0); PG8_LDB(B1, 0, 1); PG8_SCHED; PG8_LDA(At, 0, 0); PG8_STAGE(PG8_SA(1, 1), a1 + hstep, voffA);
            PG8_WAIT_V(8); PG8_WAIT_L(0); PG8_BAR; PG8_MMA(0, 0, At, B0); PG8_MMA(0, 1, At, B1); PG8_BAR; PG8_SCHED;
            PG8_LDA(At, 0, 1); PG8_STAGE(PG8_SB(0, 0), b2, voffB); PG8_STAGE(PG8_SB(0, 1), b2 + hstep, voffB); PG8_STAGE(PG8_SA(0, 0), a2, voffA);
            PG8_WAIT_V(8); PG8_WAIT_L(0); PG8_BAR; PG8_MMA(1, 0, At, B0); PG8_MMA(1, 1, At, B1); PG8_BAR; PG8_SCHED;
            PG8_LDB(B0, 1, 0); PG8_LDB(B1, 1, 1); PG8_SCHED; PG8_LDA(At, 1, 0); PG8_STAGE(PG8_SA(0, 1), a2 + hstep, voffA);
            PG8_WAIT_V(8); PG8_WAIT_L(0); PG8_BAR; PG8_MMA(0, 0, At, B0); PG8_MMA(0, 1, At, B1); PG8_BAR; PG8_SCHED;
            PG8_LDA(At, 1, 1); PG8_STAGE(PG8_SB(1, 0), b3, voffB); PG8_STAGE(PG8_SB(1, 1), b3 + hstep, voffB); PG8_STAGE(PG8_SA(1, 0), a3, voffA);
            PG8_WAIT_V(8); PG8_WAIT_L(0); PG8_BAR; PG8_MMA(1, 0, At, B0); PG8_MMA(1, 1, At, B1); PG8_BAR; PG8_SCHED;
            } else {
            PG8_LDB(B0, 0, 0); PG8_SCHED; PG8_LDA(At, 0, 0); PG8_STAGE(PG8_SA(1, 1), a1 + hstep, voffA);
            PG8_WAIT_L(8); PG8_BAR; PG8_WAIT_L(0); PG8_MMA(0, 0, At, B0); PG8_BAR; PG8_SCHED;
            PG8_LDB(B1, 0, 1); PG8_STAGE(PG8_SB(0, 0), b2, voffB);
            PG8_BAR; PG8_WAIT_L(0); PG8_MMA(0, 1, At, B1); PG8_BAR;
            PG8_LDA(At, 0, 1); PG8_STAGE(PG8_SA(0, 0), a2, voffA);
            PG8_BAR; PG8_WAIT_L(0); PG8_MMA(1, 0, At, B0); PG8_BAR; PG8_SCHED;
            PG8_STAGE(PG8_SB(0, 1), b2 + hstep, voffB);
            PG8_WAIT_V(6); PG8_BAR; PG8_MMA(1, 1, At, B1); PG8_BAR;
            PG8_LDB(B0, 1, 0); PG8_SCHED; PG8_LDA(At, 1, 0); PG8_STAGE(PG8_SA(0, 1), a2 + hstep, voffA);
            PG8_WAIT_L(8); PG8_BAR; PG8_WAIT_L(0); PG8_MMA(0, 0, At, B0); PG8_BAR; PG8_SCHED;
            PG8_LDB(B1, 1, 1); PG8_STAGE(PG8_SB(1, 0), b3, voffB);
            PG8_BAR; PG8_WAIT_L(0); PG8_MMA(0, 1, At, B1); PG8_BAR;
            PG8_LDA(At, 1, 1); PG8_STAGE(PG8_SA(1, 0), a3, voffA);
            PG8_BAR; PG8_WAIT_L(0); PG8_MMA(1, 0, At, B0); PG8_BAR; PG8_SCHED;
            PG8_STAGE(PG8_SB(1, 1), b3 + hstep, voffB);
            PG8_WAIT_V(6); PG8_BAR; PG8_MMA(1, 1, At, B1); PG8_BAR;
            }
        }
        if constexpr (ALIGN_EPI) { if (wr == 0) PG8_BAR; }
        if constexpr (!Epi::AFTER_DRAIN) { E(acc, cur, wr, wc, fr, fq); S.done(cur); }
        if (!has_next) break;
#pragma unroll
        for (int a = 0; a < 2; ++a)
#pragma unroll
            for (int b = 0; b < 2; ++b)
#pragma unroll
                for (int m = 0; m < 4; ++m)
#pragma unroll
                    for (int n = 0; n < 2; ++n) acc[a][b][m][n] = (f32x4){0.f, 0.f, 0.f, 0.f};
        cur = nxt; cA = nA; cB = nB; ++ui;
        if constexpr (ALIGN_EPI) { if (wr == 1) PG8_BAR; }
    }
    PG8_WAIT_V(0);
    if constexpr (!ALIGN_EPI) { if (wr == 0) PG8_BAR; }
    PG8_BAR;
    if constexpr (Epi::AFTER_DRAIN) { E.fused(acc, cur, wr, wc, fr, fq, lds, wid, lane); S.done(cur); }
#undef PG8_SA
#undef PG8_SB
#undef PG8_STAGE
#undef PG8_LDA
#undef PG8_LDB
#undef PG8_MMA
#undef PG8_WAIT_V
#undef PG8_WAIT_L
#undef PG8_BAR
#undef PG8_SCHED
}
}

constexpr int NWAVES = 8;
constexpr int BATCH = 2, SEQ = 4096, DM = 4096, M = BATCH * SEQ;
constexpr int NHEAD = 32, NKVH = 8, HD = 128, NQ = 4096, NKV = 1024, NQK = NQ + NKV, NQKV = NQ + 2 * NKV;
constexpr int FFH = 11008, NGU = 2 * FFH, NCI = 3 * DM;
constexpr float ALPHA = 1.4142135623730951f;
constexpr float LN_EPS = 1e-5f;
constexpr int NPHASE = 15;

constexpr size_t MiB = 1u << 20;
constexpr size_t WS_CTL = 0, CTL_ZERO_BYTES = 1 * MiB;
constexpr size_t WS_WQKV = 2 * MiB;
constexpr size_t WS_WV = WS_WQKV + (size_t)NQK * DM * 2;
constexpr size_t WS_WO = 50 * MiB;
constexpr size_t WS_WCI = 82 * MiB;
constexpr size_t WS_WCO = 178 * MiB;
constexpr size_t WS_WGU0 = 210 * MiB, WS_WGU1 = 382 * MiB;
constexpr size_t WS_WD0 = 554 * MiB, WS_WD1 = 640 * MiB;
constexpr size_t WS_XB = 726 * MiB;
constexpr size_t WS_QK = 790 * MiB;
constexpr size_t WS_VT = 870 * MiB;
constexpr size_t WS_O = 886 * MiB;
constexpr size_t WS_Y = 950 * MiB;
constexpr size_t WS_X = 1078 * MiB;
constexpr size_t WS_ST = WS_X + 64 * MiB;
constexpr size_t WS_H = 1206 * MiB;
constexpr size_t WS_U = 1378 * MiB, WS_BG = 1442 * MiB;
constexpr size_t WS_C = 1506 * MiB;
constexpr size_t WS_END = 2194 * MiB;
static_assert(WS_WV + (size_t)NKV * DM * 2 == WS_WO && WS_WO + (size_t)DM * DM * 2 == WS_WCI && WS_WCI + (size_t)NCI * DM * 2 == WS_WCO && WS_WCO + (size_t)DM * DM * 2 == WS_WGU0, "ws map 1");
static_assert(WS_WGU0 + (size_t)NGU * DM * 2 == WS_WGU1 && WS_WGU1 + (size_t)NGU * DM * 2 == WS_WD0 && WS_WD0 + (size_t)DM * FFH * 2 == WS_WD1 && WS_WD1 + (size_t)DM * FFH * 2 == WS_XB, "ws map 2");
static_assert(WS_XB + (size_t)M * DM * 2 == WS_QK && WS_QK + (size_t)M * NQK * 2 == WS_VT && WS_VT + (size_t)NKV * M * 2 == WS_O && WS_O + (size_t)M * DM * 2 == WS_Y && WS_Y + (size_t)M * DM * 4 == WS_X, "ws map 3");
static_assert(WS_X + (size_t)M * DM * 4 == WS_H && WS_H + (size_t)M * FFH * 2 == WS_U && WS_U + (size_t)M * DM * 2 == WS_BG && WS_BG + (size_t)M * DM * 2 == WS_C && WS_C + (size_t)M * NGU * 4 == WS_END, "ws map 4");
constexpr int CW_TMO = 0;
constexpr int CW_GRP = 32768, N_GSEAM = 11, GRP_SIZE = 8;
static_assert((CW_GRP + N_GSEAM * 32 * 64) * 4 <= (int)CTL_ZERO_BYTES, "CTL words inside the memset region");
constexpr int MIX_RANKS = 6;
constexpr int CW_BAR2 = 8192, CW_Q = 12288;
constexpr int CW_BAR = 4096;

constexpr int RING_OFF = 0, RING_BYTES = 131072;
constexpr int LDSCTL_OFF = RING_BYTES, MISC_OFF = LDSCTL_OFF + 320;
constexpr int LDS_BYTES = 147456;

#define GAS __attribute__((address_space(1)))
#define LAS __attribute__((address_space(3)))
typedef unsigned short bf16;
typedef unsigned v4u __attribute__((ext_vector_type(4)));
typedef unsigned v2u __attribute__((ext_vector_type(2)));
typedef float f32x4 __attribute__((ext_vector_type(4)));
typedef float f32x16 __attribute__((ext_vector_type(16)));
typedef short bf16x8 __attribute__((ext_vector_type(8)));
typedef GAS unsigned gu32;
#define RLX_AGENT __ATOMIC_RELAXED, __HIP_MEMORY_SCOPE_AGENT
#define LDS_WAIT() asm volatile("s_waitcnt lgkmcnt(0)" ::: "memory")
typedef float f32x2 __attribute__((ext_vector_type(2)));
typedef __bf16 bf16x2_t __attribute__((ext_vector_type(2)));
__device__ __forceinline__ unsigned pk2(float lo, float hi) { const f32x2 v = {lo, hi}; return __builtin_bit_cast(unsigned, __builtin_convertvector(v, bf16x2_t)); }
__device__ __forceinline__ unsigned f2bf(float f) { return pk2(f, 0.f) & 0xffffu; }
__device__ __forceinline__ float bf2f(unsigned h) { return __builtin_bit_cast(float, h << 16); }
typedef _Float16 f16x2 __attribute__((ext_vector_type(2)));
__device__ __forceinline__ unsigned pk2h(float lo, float hi) { const f32x2 v = {lo, hi}; return __builtin_bit_cast(unsigned, __builtin_convertvector(v, f16x2)); }
__device__ __forceinline__ float h2f(unsigned h) { return (float)__builtin_bit_cast(_Float16, (unsigned short)h); }
#define MFMA32(a, b, c) __builtin_amdgcn_mfma_f32_32x32x16_bf16((a), (b), (c), 0, 0, 0)

namespace att {
typedef bf16x8 h16x8q;
constexpr int K_OFF = 0, VT_OFF = 65536;
constexpr float LOG2E = 1.4426950408889634f;
__device__ __forceinline__ void attn_unit(LAS unsigned char* lds, const bf16* __restrict__ QK, const bf16* __restrict__ VT, bf16* __restrict__ O, const float* __restrict__ sinks, int b, int g, int qb) {
    int tid_ = threadIdx.x; asm volatile("" : "+v"(tid_));
    const int tid = tid_, lane = tid & 63, r32 = lane & 31, hi = lane >> 5; const int wid = __builtin_amdgcn_readfirstlane(tid >> 6);
    const int q0 = qb * 128; const long rowbase = (long)b * SEQ;
    const int hh = wid >> 1, h = g * 4 + hh;
    h16x8q qf2[2][8];
#pragma unroll
    for (int t = 0; t < 2; ++t) { const bf16* qp = QK + (size_t)(rowbase + q0 + 32 * (2 * (wid & 1) + t) + r32) * NQK + h * HD + hi * 8;
#pragma unroll
        for (int ds = 0; ds < 8; ++ds) qf2[t][ds] = *(const h16x8q*)(qp + 16 * ds); }
    __syncthreads();
#pragma unroll
    for (int it = 0; it < 8; ++it) { const int idx = it * 512 + tid, key = idx >> 4, c = idx & 15; int pos = q0 - 128 + key; if (pos < 0) pos += 128;
        const v4u v = *(const v4u*)(QK + (size_t)(rowbase + pos) * NQK + NQ + g * HD + c * 8);
        *(LAS v4u*)(lds + K_OFF + key * 256 + ((c ^ (key & 15)) << 4)) = v; }
#pragma unroll
    for (int it = 0; it < 8; ++it) { const int idx = it * 512 + tid, d = idx >> 5, c = idx & 31; int pos = q0 - 128 + c * 8; if (pos < 0) pos += 128;
        const v4u v = *(const v4u*)(VT + (size_t)(g * HD + d) * M + rowbase + pos);
        *(LAS v4u*)(lds + VT_OFF + d * 512 + ((c ^ (d & 15)) << 4)) = v; }
    __syncthreads();
    const float sink2 = sinks[h] * LOG2E, sc = 0.08838834764831845f * LOG2E;
    const int pi = (r32 & ~12) | ((r32 & 4) << 1) | ((r32 & 8) >> 1);
#pragma unroll
    for (int t = 0; t < 2; ++t) {
        const int j = 2 * (wid & 1) + t;
        const h16x8q (&qf)[8] = qf2[t];
        f32x16 st[5];
#pragma unroll
        for (int kt = 0; kt < 5; ++kt) {
#pragma unroll
            for (int r = 0; r < 16; ++r) st[kt][r] = 0.f;
            const int kr = 32 * (j + kt) + pi; const LAS unsigned char* kp = lds + K_OFF + kr * 256;
#pragma unroll
            for (int ds = 0; ds < 8; ++ds) { const int c = 2 * ds + hi; const bf16x8 kf = *(const LAS bf16x8*)(kp + ((c ^ (kr & 15)) << 4)); st[kt] = MFMA32(kf, qf[ds], st[kt]); }
        }
        float mx = sink2;
#pragma unroll
        for (int kt = 0; kt < 5; ++kt)
#pragma unroll
            for (int r = 0; r < 16; ++r) { const int i = 16 * (r >> 3) + 8 * hi + (r & 7);
                bool ok = true; if (kt == 0) ok = i > r32; if (kt == 4) ok = i <= r32; if (q0 == 0 && j + kt < 4) ok = false;
                const float s = ok ? st[kt][r] * sc : -INFINITY; st[kt][r] = s; mx = fmaxf(mx, s); }
        mx = fmaxf(mx, __shfl_xor(mx, 32));
        float sum = 0.f;
#pragma unroll
        for (int kt = 0; kt < 5; ++kt)
#pragma unroll
            for (int r = 0; r < 16; ++r) { const float p = __builtin_amdgcn_exp2f(st[kt][r] - mx); st[kt][r] = p; sum += p; }
        sum += __shfl_xor(sum, 32);
        const float inv = 1.0f / (sum + __builtin_amdgcn_exp2f(sink2 - mx));
        bf16x8 pb[5][2];
#pragma unroll
        for (int kt = 0; kt < 5; ++kt)
#pragma unroll
            for (int m = 0; m < 2; ++m) { v4u w; w.x = pk2(st[kt][8 * m], st[kt][8 * m + 1]); w.y = pk2(st[kt][8 * m + 2], st[kt][8 * m + 3]); w.z = pk2(st[kt][8 * m + 4], st[kt][8 * m + 5]); w.w = pk2(st[kt][8 * m + 6], st[kt][8 * m + 7]);
                pb[kt][m] = __builtin_bit_cast(bf16x8, w); }
        const int orow = (int)rowbase + q0 + 32 * j + r32;
#pragma unroll
        for (int db = 0; db < 4; ++db) {
            f32x16 o;
#pragma unroll
            for (int r = 0; r < 16; ++r) o[r] = 0.f;
            const int d = 32 * db + r32; const LAS unsigned char* vp = lds + VT_OFF + d * 512;
#pragma unroll
            for (int kt = 0; kt < 5; ++kt)
#pragma unroll
                for (int m = 0; m < 2; ++m) { const int c = 4 * (j + kt) + 2 * m + hi; const bf16x8 vf = *(const LAS bf16x8*)(vp + ((c ^ (d & 15)) << 4)); o = MFMA32(vf, pb[kt][m], o); }
#pragma unroll
            for (int rg = 0; rg < 4; ++rg) { v2u w; w.x = pk2(o[4 * rg] * inv, o[4 * rg + 1] * inv); w.y = pk2(o[4 * rg + 2] * inv, o[4 * rg + 3] * inv);
                *(v2u*)(O + pg8::tl_off(orow, h * HD + 32 * db + 8 * rg + 4 * hi, NQ)) = w; }
        }
        asm volatile("" ::: "memory"); __builtin_amdgcn_sched_barrier(0);
    }
}
}

#define XB_TMO      128
#define XB_XCNT(j)  (256  + 64 * (j))
#define XB_XSUB(j)  (1280 + 64 * (j))
#define XB_XGEN(j)  (2304 + 64 * (j))
#define XB_TOP      3328
#define XB_TOPGEN   3392
#define XCD_BAR_WORDS 3456
#define XB_SPIN_CAP (1u << 18)

__device__ __forceinline__ unsigned xb_ld(unsigned* p)              { return __hip_atomic_load(p, __ATOMIC_RELAXED, __HIP_MEMORY_SCOPE_AGENT); }
__device__ __forceinline__ unsigned xb_add(unsigned* p, unsigned v) { return __hip_atomic_fetch_add(p, v, __ATOMIC_RELAXED, __HIP_MEMORY_SCOPE_AGENT); }
__device__ __forceinline__ unsigned xb_xcc_id() { return (unsigned)__builtin_amdgcn_s_getreg((3 << 11) | 20) & 0xFu; }
#define XB_SPIN(cond, bar) do { unsigned _sp = 0; while (cond) { __builtin_amdgcn_s_sleep(1); \
    if ((++_sp & 255u) == 0u) { if (xb_ld(&(bar)[XB_TMO])) break; if (_sp > XB_SPIN_CAP) { atomicAdd(&(bar)[XB_TMO], 1u); break; } } } } while (0)

struct XcdBarrier {
    unsigned* bar; unsigned x;
    unsigned rank;
    volatile LAS unsigned* st;
};

__device__ __forceinline__ XcdBarrier xcd_barrier_post(unsigned* bar, volatile LAS unsigned* st) {
    XcdBarrier b; b.bar = bar; b.x = xb_xcc_id(); b.st = st; b.rank = 0u;
    if (threadIdx.x == 0) b.rank = xb_add(&bar[XB_XCNT(b.x)], 1u);
    return b;
}
__device__ __forceinline__ void xcd_barrier_complete(unsigned* bar, unsigned x, unsigned& nloc, unsigned& nx) {
    const unsigned G = gridDim.x * gridDim.y * gridDim.z;
    unsigned sum, cnt, mine, sp = 0u;
    for (;;) {
        sum = 0u; cnt = 0u; mine = 0u;
#pragma unroll
        for (unsigned j = 0; j < 16; ++j) { const unsigned c = xb_ld(&bar[XB_XCNT(j)]); sum += c; cnt += (c > 0u) ? 1u : 0u; mine = (j == x) ? c : mine; }
        if (sum == G) break;
        __builtin_amdgcn_s_sleep(1);
        if ((++sp & 255u) == 0u) { if (xb_ld(&bar[XB_TMO])) break; if (sp > XB_SPIN_CAP) { atomicAdd(&bar[XB_TMO], 1u); break; } }
    }
    nloc = mine > 0u ? mine : 1u; nx = cnt > 0u ? cnt : 1u;
}

__device__ __forceinline__ void xcd_barrier(const XcdBarrier& b) {
    asm volatile("s_waitcnt vmcnt(0)" ::: "memory");
    __syncthreads();
    if (threadIdx.x == 0) {
        unsigned* bar = b.bar;
        __builtin_amdgcn_s_waitcnt(0);
        unsigned nloc = b.st[0], nx = b.st[1];
        if (nloc == 0u) { xcd_barrier_complete(bar, b.x, nloc, nx); b.st[0] = nloc; b.st[1] = nx; }
        const unsigned old = xb_add(&bar[XB_XSUB(b.x)], 1u);
        const unsigned gen = old / nloc;
        if (old + 1u == (gen + 1u) * nloc) {
            __builtin_amdgcn_fence(__ATOMIC_RELEASE, "agent");
            asm volatile("s_waitcnt vmcnt(0)" ::: "memory");
            const unsigned og = xb_add(&bar[XB_TOP], 1u);
            const unsigned tg = og / nx;
            if (og + 1u == (tg + 1u) * nx) xb_add(&bar[XB_TOPGEN], 1u);
            else XB_SPIN(xb_ld(&bar[XB_TOPGEN]) == tg, bar);
            __builtin_amdgcn_fence(__ATOMIC_ACQUIRE, "agent");
            xb_add(&bar[XB_XGEN(b.x)], 1u);
            asm volatile("s_waitcnt vmcnt(0)" ::: "memory");
        } else {
            XB_SPIN(xb_ld(&bar[XB_XGEN(b.x)]) == gen, bar);
            __builtin_amdgcn_fence(__ATOMIC_ACQUIRE, "agent");
            asm volatile("s_waitcnt vmcnt(0)" ::: "memory");
        }
    }
    __syncthreads();
}

__device__ __forceinline__ void sub_barrier(unsigned* bar, unsigned x, unsigned nloc, unsigned nx) {
    asm volatile("s_waitcnt vmcnt(0)" ::: "memory");
    __syncthreads();
    if (threadIdx.x == 0) {
        __builtin_amdgcn_s_waitcnt(0);
        const unsigned old = xb_add(&bar[XB_XSUB(x)], 1u);
        const unsigned gen = old / nloc;
        if (old + 1u == (gen + 1u) * nloc) {
            __builtin_amdgcn_fence(__ATOMIC_RELEASE, "agent");
            asm volatile("s_waitcnt vmcnt(0)" ::: "memory");
            const unsigned og = xb_add(&bar[XB_TOP], 1u);
            const unsigned tg = og / nx;
            if (og + 1u == (tg + 1u) * nx) xb_add(&bar[XB_TOPGEN], 1u);
            else XB_SPIN(xb_ld(&bar[XB_TOPGEN]) == tg, bar);
            __builtin_amdgcn_fence(__ATOMIC_ACQUIRE, "agent");
            xb_add(&bar[XB_XGEN(x)], 1u);
            asm volatile("s_waitcnt vmcnt(0)" ::: "memory");
        } else {
            XB_SPIN(xb_ld(&bar[XB_XGEN(x)]) == gen, bar);
            __builtin_amdgcn_fence(__ATOMIC_ACQUIRE, "agent");
            asm volatile("s_waitcnt vmcnt(0)" ::: "memory");
        }
    }
    __syncthreads();
}

struct Frame {
    LAS unsigned char* lds;
    volatile LAS unsigned* MISC;
    gu32* ctl;
    int tid, wave, vcu, G;
};
__device__ __forceinline__ float wave_sum(float v) {
#pragma unroll
    for (int o = 1; o < 64; o <<= 1) v += __shfl_xor(v, o);
    return v;
}
__device__ __forceinline__ void group_barrier(Frame& F, int seam, int pm, int size) {
    asm volatile("s_waitcnt vmcnt(0)" ::: "memory");
    __syncthreads();
    if (F.tid == 0) {
        gu32* cnt = F.ctl + CW_GRP + (seam * 32 + pm) * 64;
        (void)__hip_atomic_fetch_add(cnt, 1u, RLX_AGENT);
        unsigned sp = 0;
        while (__hip_atomic_load(cnt, RLX_AGENT) < (unsigned)size) { __builtin_amdgcn_s_sleep(1);
            if ((++sp & 255u) == 0u) { if (__hip_atomic_load(F.ctl + CW_TMO, RLX_AGENT)) break; if (sp > (1u << 18)) { __hip_atomic_store(F.ctl + CW_TMO, 1u, RLX_AGENT); break; } } }
        __builtin_amdgcn_fence(__ATOMIC_ACQUIRE, "agent");
        asm volatile("s_waitcnt vmcnt(0)" ::: "memory");
    }
    __syncthreads();
}
struct TItem { const float* W; bf16* WT; int K, N, k0, n0, drow0; };
__device__ __forceinline__ void t_load(const TItem& I, f32x4 (&ra)[8], f32x4 (&rb)[8], int lane) {
    const int q = lane & 15, pr = lane >> 4;
#pragma unroll
    for (int i = 0; i < 8; ++i) { const GAS float* src = (const GAS float*)I.W + (size_t)(I.k0 + 2 * (4 * i + pr)) * I.N + I.n0 + 4 * q; ra[i] = __builtin_nontemporal_load((const GAS f32x4*)src); rb[i] = __builtin_nontemporal_load((const GAS f32x4*)(src + I.N)); }
}
__device__ __forceinline__ void t_write_lds(LAS unsigned* T, const f32x4 (&ra)[8], const f32x4 (&rb)[8], int lane) {
    const int q = lane & 15, pr = lane >> 4;
#pragma unroll
    for (int i = 0; i < 8; ++i) { const int p = 4 * i + pr; v4u u; u.x = pk2(ra[i].x, rb[i].x); u.y = pk2(ra[i].y, rb[i].y); u.z = pk2(ra[i].z, rb[i].z); u.w = pk2(ra[i].w, rb[i].w);
        *(LAS v4u*)(T + p * 64 + ((q ^ ((p >> 2) & 7)) << 2)) = u; }
}
__device__ __forceinline__ void t_read_store(const LAS unsigned* T, const TItem& I, int lane) {
    const int c = lane & 7, nb = lane >> 3;
#pragma unroll
    for (int jj = 0; jj < 8; ++jj) { const int n = nb + 8 * jj, q = n >> 2, j = n & 3; const LAS unsigned* s = T + (4 * c) * 64 + ((q ^ c) << 2) + j;
        v4u o; o.x = s[0]; o.y = s[64]; o.z = s[128]; o.w = s[192];
        __builtin_nontemporal_store(o, (GAS v4u*)(I.WT + pg8::tl_off(I.drow0 + n, I.k0 + 8 * c, I.K))); }
}
__device__ __forceinline__ int map_pair128(int n, int half_n) {
    const int second = n >= half_n ? 1 : 0, nn = n - second * half_n; return (nn >> 7) * 256 + second * 128 + (nn & 127);
}
struct Ptrs {
    const float *x, *attn_w_in, *attn_sinks, *attn_w_out, *conv_w_in, *conv_w, *conv_w_out, *ln_mix_g, *ln_mix_b, *ffn_w_gate_up, *ffn_w_down, *ln_ffn_g, *ln_ffn_b;
    float* out; unsigned char* ws;
};
constexpr int I_AIN = (DM / 64) * (NQKV / 64), I_SQ = (DM / 64) * (DM / 64), I_CI = (DM / 64) * (NCI / 64), I_GU = (DM / 64) * (NGU / 64), I_DN = (FFH / 64) * (DM / 64);
constexpr int NITEMS = I_AIN + 2 * I_SQ + I_CI + 2 * I_GU + 2 * I_DN;
constexpr int N_STAGE1 = I_AIN + I_SQ;
constexpr int QCHUNK = 8;
static_assert(N_STAGE1 % QCHUNK == 0 && I_CI % QCHUNK == 0 && I_SQ % QCHUNK == 0 && I_DN % QCHUNK == 0 && I_GU % QCHUNK == 0, "a chunk never straddles two matrices");
template <bool QUEUE>
__device__ __forceinline__ void p0_items(Frame& F, const Ptrs& P, int first, int limit) {
    int lane_ = (int)(threadIdx.x & 63u); asm volatile("" : "+v"(lane_)); const int lane = lane_;
    LAS unsigned* T = (LAS unsigned*)(F.lds + RING_OFF + F.wave * 8192);
    const int gw = F.vcu * NWAVES + F.wave, NGW = F.G * NWAVES;
    unsigned char* ws = P.ws;
    auto decode = [&](int it, TItem& I) {
        int r = it;
        if (r < I_AIN) { const int nb = NQKV / 64; I.K = DM; I.N = NQKV; I.k0 = 64 * (r / nb); I.n0 = 64 * (r % nb); I.drow0 = I.n0; I.W = P.attn_w_in; I.WT = (bf16*)(ws + WS_WQKV); return; } r -= I_AIN;
        if (r < I_SQ) { const int nb = DM / 64; I.K = DM; I.N = DM; I.k0 = 64 * (r / nb); I.n0 = 64 * (r % nb); I.drow0 = I.n0; I.W = P.attn_w_out; I.WT = (bf16*)(ws + WS_WO); return; } r -= I_SQ;
        if (r < I_CI) { const int nb = NCI / 64; I.K = DM; I.N = NCI; I.k0 = 64 * (r / nb); I.n0 = 64 * (r % nb);
            I.drow0 = I.n0 < DM ? 2 * DM + I.n0 : map_pair128(I.n0 - DM, DM);
            I.W = P.conv_w_in; I.WT = (bf16*)(ws + WS_WCI); return; } r -= I_CI;
        if (r < I_SQ) { const int nb = DM / 64; I.K = DM; I.N = DM; I.k0 = 64 * (r / nb); I.n0 = 64 * (r % nb); I.drow0 = I.n0; I.W = P.conv_w_out; I.WT = (bf16*)(ws + WS_WCO); return; } r -= I_SQ;
        if (r < 2 * I_DN) { const int l = 1 - r / I_DN; r %= I_DN; const int nb = DM / 64; I.K = FFH; I.N = DM; I.k0 = 64 * (r / nb); I.n0 = 64 * (r % nb); I.drow0 = I.n0;
            I.W = P.ffn_w_down + (size_t)l * FFH * DM; I.WT = (bf16*)(ws + (l ? WS_WD1 : WS_WD0)); return; } r -= 2 * I_DN;
        { const int l = 1 - r / I_GU; r %= I_GU; const int nb = NGU / 64; I.K = DM; I.N = NGU; I.k0 = 64 * (r / nb); I.n0 = 64 * (r % nb); I.drow0 = map_pair128(I.n0, FFH);
            I.W = P.ffn_w_gate_up + (size_t)l * DM * NGU; I.WT = (bf16*)(ws + (l ? WS_WGU1 : WS_WGU0)); }
    };
    gu32* const q = F.ctl + CW_Q;
    auto pull = [&]() -> unsigned { unsigned v = 0u; if (lane == 0) v = __hip_atomic_fetch_add(q, 1u, RLX_AGENT); return v; };
    {
        int it; unsigned nxc = 0u; TItem cur, nxt; f32x4 ra[8], rb[8];
        if constexpr (QUEUE) { const unsigned c0 = pull(); nxc = pull(); it = first + QCHUNK * (int)__builtin_amdgcn_readfirstlane(c0); } else it = first + gw;
        if (it < limit) { decode(it, cur); t_load(cur, ra, rb, lane); }
        while (it < limit) {
            t_write_lds(T, ra, rb, lane);
            int nit;
            if constexpr (QUEUE) { nit = it + 1; if (((nit - first) & (QCHUNK - 1)) == 0) { nit = first + QCHUNK * (int)__builtin_amdgcn_readfirstlane(nxc); nxc = pull(); } } else nit = it + NGW;
            if (nit < limit) { decode(nit, nxt); t_load(nxt, ra, rb, lane); }
            LDS_WAIT(); asm volatile("" ::: "memory");
            t_read_store(T, cur, lane);
            LDS_WAIT(); asm volatile("" ::: "memory");
            cur = nxt; it = nit;
        }
    }
}
__device__ __forceinline__ void p0_x(Frame& F, const Ptrs& P) {
    const int lane = (int)(threadIdx.x & 63u);
    unsigned char* ws = P.ws;
    { const size_t nchunk = (size_t)M * DM / 8; const size_t gt = (size_t)(F.vcu * NWAVES + F.wave) * 64 + lane, NT = (size_t)F.G * NWAVES * 64;
      const GAS f32x4* xs = (const GAS f32x4*)P.x; GAS v4u* xh = (GAS v4u*)(ws + WS_X);
      for (size_t c = gt; c < nchunk; c += NT) { const f32x4 a = xs[2 * c], b2 = xs[2 * c + 1]; v4u o; o.x = pk2(a.x, a.y); o.y = pk2(a.z, a.w); o.z = pk2(b2.x, b2.y); o.w = pk2(b2.z, b2.w); *(GAS v4u*)((GAS bf16*)(ws + WS_XB) + pg8::tl_off((int)(c >> 9), (int)(c & 511) * 8, DM)) = o;
                                               v4u h; h.x = pk2h(a.x, a.y); h.y = pk2h(a.z, a.w); h.z = pk2h(b2.x, b2.y); h.w = pk2h(b2.z, b2.w); xh[c] = h; } }
}
__device__ __forceinline__ void ln_phase(Frame& F, const bf16* __restrict__ Y, const float* __restrict__ gam, const float* __restrict__ bet, float* __restrict__ XO, bf16* __restrict__ XBO, float* __restrict__ ST, int mbeg, int mend, int mstep) {
    int lane_ = (int)(threadIdx.x & 63u); asm volatile("" : "+v"(lane_)); const int lane = lane_;
    for (int m = mbeg; m < mend; m += mstep) {
        asm volatile("" ::: "memory");
        const GAS v4u* yr = (const GAS v4u*)(Y + (size_t)m * DM) + lane;
        v4u raw[8];
#pragma unroll
        for (int j = 0; j < 8; ++j) raw[j] = __builtin_nontemporal_load(yr + 64 * j);
        float v[8][8]; float s = 0.f;
#pragma unroll
        for (int j = 0; j < 8; ++j) { v[j][0] = h2f(raw[j].x & 0xffffu); v[j][1] = h2f(raw[j].x >> 16); v[j][2] = h2f(raw[j].y & 0xffffu); v[j][3] = h2f(raw[j].y >> 16);
            v[j][4] = h2f(raw[j].z & 0xffffu); v[j][5] = h2f(raw[j].z >> 16); v[j][6] = h2f(raw[j].w & 0xffffu); v[j][7] = h2f(raw[j].w >> 16);
            s += ((v[j][0] + v[j][1]) + (v[j][2] + v[j][3])) + ((v[j][4] + v[j][5]) + (v[j][6] + v[j][7])); }
        const float mean = wave_sum(s) * (1.f / DM); float s2 = 0.f;
#pragma unroll
        for (int j = 0; j < 8; ++j)
#pragma unroll
            for (int e = 0; e < 8; ++e) { v[j][e] -= mean; s2 += v[j][e] * v[j][e]; }
        const float rstd = 1.f / sqrtf(wave_sum(s2) * (1.f / DM) + LN_EPS);
        if (ST && lane == 0) *(GAS f32x2*)(ST + 2 * (size_t)m) = (f32x2){mean, rstd};
        const GAS f32x4* gp = (const GAS f32x4*)gam + 2 * lane; const GAS f32x4* bp = (const GAS f32x4*)bet + 2 * lane;
#pragma unroll
        for (int j = 0; j < 8; ++j) { const f32x4 g0 = gp[128 * j], g1 = gp[128 * j + 1], b0 = bp[128 * j], b1 = bp[128 * j + 1];
            const f32x4 o0 = (f32x4){v[j][0], v[j][1], v[j][2], v[j][3]} * rstd * g0 + b0, o1 = (f32x4){v[j][4], v[j][5], v[j][6], v[j][7]} * rstd * g1 + b1;
            if (XBO) { v4u w; w.x = pk2(o0.x, o0.y); w.y = pk2(o0.z, o0.w); w.z = pk2(o1.x, o1.y); w.w = pk2(o1.z, o1.w); *(GAS v4u*)(XBO + pg8::tl_off(m, 512 * j + 8 * lane, DM)) = w;
                       }
            else { GAS f32x4* xo = (GAS f32x4*)(XO + (size_t)m * DM) + 2 * lane + 128 * j; xo[0] = o0; xo[1] = o1; } }
    }
}
__device__ __forceinline__ void conv_phase(Frame& F, const bf16* __restrict__ U, const bf16* __restrict__ BG, const float* __restrict__ cw, bf16* __restrict__ V2, int jbeg, int jend, int jstep) {
    constexpr int NSEG = M / 32, NJOB = NSEG * 8;
    int lane_ = (int)(threadIdx.x & 63u); asm volatile("" : "+v"(lane_)); const int lane = lane_;
    for (int job = jbeg; job < jend; job += jstep) {
        const int cg = job & 7, seg = job >> 3, c0 = cg * 512 + lane * 8, r0 = seg * 32;
        float w0[8], w1[8], w2[8];
#pragma unroll
        for (int e = 0; e < 8; ++e) { w0[e] = cw[c0 + e]; w1[e] = cw[DM + c0 + e]; w2[e] = cw[2 * DM + c0 + e]; }
        float u1[8], u2[8];
        if ((r0 % SEQ) == 0) {
#pragma unroll
            for (int e = 0; e < 8; ++e) { u1[e] = 0.f; u2[e] = 0.f; }
        } else {
            const v4u a = *(const v4u*)(U + (size_t)(r0 - 1) * DM + c0), b2 = *(const v4u*)(U + (size_t)(r0 - 2) * DM + c0);
            u1[0] = bf2f(a.x & 0xffffu); u1[1] = bf2f(a.x >> 16); u1[2] = bf2f(a.y & 0xffffu); u1[3] = bf2f(a.y >> 16); u1[4] = bf2f(a.z & 0xffffu); u1[5] = bf2f(a.z >> 16); u1[6] = bf2f(a.w & 0xffffu); u1[7] = bf2f(a.w >> 16);
            u2[0] = bf2f(b2.x & 0xffffu); u2[1] = bf2f(b2.x >> 16); u2[2] = bf2f(b2.y & 0xffffu); u2[3] = bf2f(b2.y >> 16); u2[4] = bf2f(b2.z & 0xffffu); u2[5] = bf2f(b2.z >> 16); u2[6] = bf2f(b2.w & 0xffffu); u2[7] = bf2f(b2.w >> 16);
        }
#pragma unroll 4
        for (int t = 0; t < 32; ++t) {
            const v4u a = __builtin_nontemporal_load((const v4u*)(U + (size_t)(r0 + t) * DM + c0)), g4 = __builtin_nontemporal_load((const v4u*)(BG + (size_t)(r0 + t) * DM + c0));
            float u0[8], bg[8];
            u0[0] = bf2f(a.x & 0xffffu); u0[1] = bf2f(a.x >> 16); u0[2] = bf2f(a.y & 0xffffu); u0[3] = bf2f(a.y >> 16); u0[4] = bf2f(a.z & 0xffffu); u0[5] = bf2f(a.z >> 16); u0[6] = bf2f(a.w & 0xffffu); u0[7] = bf2f(a.w >> 16);
            bg[0] = bf2f(g4.x & 0xffffu); bg[1] = bf2f(g4.x >> 16); bg[2] = bf2f(g4.y & 0xffffu); bg[3] = bf2f(g4.y >> 16); bg[4] = bf2f(g4.z & 0xffffu); bg[5] = bf2f(g4.z >> 16); bg[6] = bf2f(g4.w & 0xffffu); bg[7] = bf2f(g4.w >> 16);
            float o[8];
#pragma unroll
            for (int e = 0; e < 8; ++e) { o[e] = bg[e] * (w0[e] * u2[e] + w1[e] * u1[e] + w2[e] * u0[e]); u2[e] = u1[e]; u1[e] = u0[e]; }
            v4u w; w.x = pk2(o[0], o[1]); w.y = pk2(o[2], o[3]); w.z = pk2(o[4], o[5]); w.w = pk2(o[6], o[7]);
            *(v4u*)(V2 + pg8::tl_off(r0 + t, c0, DM)) = w;
        }
    }
}

struct Args { const float* in[13]; float* out; unsigned char* ws; int ph_lo, ph_hi, use_bar, pad; };
__global__ void __launch_bounds__(NWAVES * 64, 2) mk_fwd(Args args) {
    extern __shared__ __attribute__((aligned(16))) unsigned char lds[];
    Frame F;
    F.lds = (LAS unsigned char*)lds;
    F.MISC = (volatile LAS unsigned*)(F.lds + MISC_OFF);
    F.tid = threadIdx.x; F.wave = __builtin_amdgcn_readfirstlane(F.tid >> 6);
    F.G = gridDim.x; { const int bx = blockIdx.x; F.vcu = (F.G % 8 == 0) ? (bx % 8) * (F.G / 8) + bx / 8 : bx; }
    unsigned char* ws = args.ws;
    F.ctl = (gu32*)(ws + WS_CTL);
    Ptrs P;
    P.x = args.in[0]; P.attn_w_in = args.in[1]; P.attn_sinks = args.in[2]; P.attn_w_out = args.in[3]; P.conv_w_in = args.in[4]; P.conv_w = args.in[5]; P.conv_w_out = args.in[6];
    P.ln_mix_g = args.in[7]; P.ln_mix_b = args.in[8]; P.ffn_w_gate_up = args.in[9]; P.ffn_w_down = args.in[10]; P.ln_ffn_g = args.in[11]; P.ln_ffn_b = args.in[12]; P.out = args.out; P.ws = ws;
    for (int u = F.tid; u < (LDS_BYTES - LDSCTL_OFF) / 4; u += NWAVES * 64) ((LAS unsigned*)(F.lds + LDSCTL_OFF))[u] = 0u;
    __syncthreads();
    XcdBarrier bar; bar.bar = (unsigned*)(F.ctl + CW_BAR); bar.x = 0; bar.st = nullptr; bar.rank = 0u;
    if (args.use_bar) { bar = xcd_barrier_post((unsigned*)(F.ctl + CW_BAR), F.MISC + 8); if (F.tid == 0) { F.MISC[10] = bar.rank; F.MISC[11] = bar.x; } }
    bool pl = false;
    int cidx = (int)blockIdx.x;
#if DEV_MODE
    const int lo = args.ph_lo, hi = args.ph_hi;
#else
    constexpr int lo = 0, hi = NPHASE;
#endif
#define IN(k) (lo <= (k) && (k) < hi)
#define SEAM(k) do { if (IN(k) && IN((k) + 1)) xcd_barrier(bar); } while (0)
#define GSEAM(k, size) do { if (IN(k) && IN((k) + 1)) { if (pl) group_barrier(F, (k) - 3, pmg, size); else xcd_barrier(bar); } } while (0)
#define PHASE_BEGIN(k) if (IN(k)) {
#define PHASE_END }

    PHASE_BEGIN(0) { p0_x(F, P); p0_items<false>(F, P, 0, args.use_bar ? N_STAGE1 : NITEMS); } PHASE_END
    SEAM(0);
    if (args.use_bar && IN(0) && IN(1)) {
        if (F.tid == 0) { bool ok = (F.G % 8) == 0;
            for (unsigned j = 0; j < 16; ++j) { const unsigned c = xb_ld(&bar.bar[XB_XCNT(j)]); ok = ok && (c == (j < 8u ? (unsigned)F.G / 8u : 0u)); }
            F.MISC[12] = ok ? 1u : 0u; }
        __syncthreads();
        if (F.MISC[12] != 0u) cidx = (int)(F.MISC[10] * 8u + F.MISC[11]);
        cidx = __builtin_amdgcn_readfirstlane(cidx);
        if (F.G % 8 == 0) F.vcu = (cidx % 8) * (F.G / 8) + cidx / 8;
        pl = (F.MISC[12] != 0u) && F.G == 256;
    }
    const int pmg = 4 * (cidx & 7) + ((cidx >> 3) & 3), rankg = cidx >> 5;
    const int gwv = F.vcu * NWAVES + F.wave, NGWV = F.G * NWAVES;
    const bool split = pl, conv_role = pl && rankg >= MIX_RANKS;
    if (args.use_bar && IN(0) && IN(1)) {
        if (!split || conv_role) p0_items<true>(F, P, N_STAGE1, NITEMS);
        if (!split) xcd_barrier(bar);
    }
#pragma unroll 1
    for (int layer = 0; layer < 2; ++layer) {
        const int pb = 1 + 7 * layer;
        { GAS unsigned char* wl = (GAS unsigned char*)args.ws; asm volatile("" : "+s"(wl)); ws = (unsigned char*)wl; }
        bf16* const XB = (bf16*)(ws + WS_XB); bf16* const QKb = (bf16*)(ws + WS_QK); bf16* const VTb = (bf16*)(ws + WS_VT); bf16* const Ob = (bf16*)(ws + WS_O);
        bf16* const Yh = (bf16*)(ws + WS_Y); bf16* const XH = (bf16*)(ws + WS_X); float* const STf = (float*)(ws + WS_ST); bf16* const Hb = (bf16*)(ws + WS_H); bf16* const Ub = (bf16*)(ws + WS_U); bf16* const BGb = (bf16*)(ws + WS_BG);
        if (layer == 0) {
          if (!conv_role) {
            PHASE_BEGIN(1) {
                { pg8::Gemm g{XB, (const bf16*)(ws + WS_WQKV), M, NQK, DM}; pg8::StaticOrder S; S.init(M, NQK, F.G, cidx);
                  if (split) S.init_panel(NQK / 256, pmg, rankg, MIX_RANKS);
                  pg8::EpiBf16 E{QKb, NQK};
                  pg8::gemm_phase<pg8::EpiBf16, pg8::StaticOrder, true, true>(F.lds + RING_OFF, g, S, E); }
                { pg8::Gemm g{(const bf16*)(ws + WS_WV), XB, NKV, M, DM}; pg8::StaticOrder S; S.init(NKV, M, F.G, (cidx + F.G / 2) % F.G);
                  if (split) { const int off = (rankg - 2) * 4 + ((cidx >> 3) & 3);
                      const int pnv = 4 * (cidx & 7) + (off >> 2); S.init_panel(rankg >= 2 ? pnv + 1 : 0, off & 3, rankg >= 2 ? pnv : 0, 1 << 20); }
                  pg8::EpiBf16 E{VTb, M};
                  pg8::gemm_phase<pg8::EpiBf16, pg8::StaticOrder, true, true>(F.lds + RING_OFF, g, S, E); }
            } PHASE_END
            if (IN(1) && IN(2)) { if (split) sub_barrier((unsigned*)(F.ctl + CW_BAR2), bar.x, (unsigned)(4 * MIX_RANKS), 8u); else xcd_barrier(bar); }
            PHASE_BEGIN(2) {
                const int i0 = split ? (cidx >> 3) : F.vcu, iend = split ? 2 * (SEQ / 128) : BATCH * NKVH * (SEQ / 128), istep = split ? 4 * MIX_RANKS : F.G;
                for (int i = i0; i < iend; i += istep) { const int u = split ? ((i >> 5) * 256 + (cidx & 7) * 32 + (i & 31)) : i;
                    att::attn_unit(F.lds + RING_OFF, QKb, VTb, Ob, P.attn_sinks, u >> 8, (u >> 5) & 7, u & 31); }
            } PHASE_END
            if (IN(2) && IN(3)) { if (split) sub_barrier((unsigned*)(F.ctl + CW_BAR2), bar.x, (unsigned)(4 * MIX_RANKS), 8u); else xcd_barrier(bar); }
          }
        } else {
            PHASE_BEGIN(8) {
                pg8::Gemm g{XB, (const bf16*)(ws + WS_WCI), M, NCI, DM}; pg8::StaticOrder S; S.init(M, NCI, F.G, cidx);
                pg8::EpiConvIn E{Ub, BGb, DM, DM / 128};
                pg8::gemm_phase<pg8::EpiConvIn, pg8::StaticOrder, true, true>(F.lds + RING_OFF, g, S, E);
            } PHASE_END
            SEAM(8);
            PHASE_BEGIN(9) { if (pl) { const int jb = (8 * pmg + rankg) * 8 + F.wave; conv_phase(F, Ub, BGb, P.conv_w, Ob, jb, jb + 1, 1); } else conv_phase(F, Ub, BGb, P.conv_w, Ob, gwv, (M / 32) * 8, NGWV); } PHASE_END
            GSEAM(9, GRP_SIZE);
        }
        const int nrk = (split && layer == 0) ? MIX_RANKS : GRP_SIZE;
        if (!(conv_role && layer == 0)) {
        PHASE_BEGIN(pb + 2) {
            pg8::StaticOrder S; S.init(M, DM, F.G, cidx);
            if (pl) S.init_panel(DM / 256, pmg, rankg, nrk);
            if (layer == 0) { pg8::Gemm g{Ob, (const bf16*)(ws + WS_WO), M, DM, DM}; pg8::EpiResF16 E{XH, Yh, DM, ALPHA};
                pg8::gemm_phase<pg8::EpiResF16, pg8::StaticOrder, true, true>(F.lds + RING_OFF, g, S, E); }
            else { pg8::Gemm g{Ob, (const bf16*)(ws + WS_WCO), M, DM, DM}; pg8::EpiResLN E{Yh, DM, ALPHA, STf, P.ln_ffn_g, P.ln_ffn_b};
                pg8::gemm_phase<pg8::EpiResLN, pg8::StaticOrder, true, true>(F.lds + RING_OFF, g, S, E); }
        } PHASE_END
        GSEAM(pb + 2, nrk);
        PHASE_BEGIN(pb + 3) { const bool six = nrk != GRP_SIZE; const int mb = pl ? 256 * pmg + (six ? 8 : 32) * rankg + F.wave : gwv;
            ln_phase(F, Yh, P.ln_mix_g + layer * DM, P.ln_mix_b + layer * DM, (float*)nullptr, XB, STf, mb, pl ? (six ? 256 * pmg + 256 : 256 * pmg + 32 * rankg + 32) : M, pl ? (six ? NWAVES * MIX_RANKS : NWAVES) : NGWV); } PHASE_END
        }
        if (split && layer == 0) { if (IN(4) && IN(5)) { if (!conv_role) p0_items<true>(F, P, N_STAGE1, NITEMS); xcd_barrier(bar); } }
        else GSEAM(pb + 3, GRP_SIZE);
        PHASE_BEGIN(pb + 4) {
            pg8::Gemm g{XB, (const bf16*)(ws + (layer ? WS_WGU1 : WS_WGU0)), M, NGU, DM}; pg8::StaticOrder S; S.init(M, NGU, F.G, cidx);
            pg8::EpiSwiGLU E{Hb, FFH};
            pg8::gemm_phase<pg8::EpiSwiGLU, pg8::StaticOrder, true, true>(F.lds + RING_OFF, g, S, E);
        } PHASE_END
        GSEAM(pb + 4, GRP_SIZE);
        PHASE_BEGIN(pb + 5) {
            pg8::Gemm g{Hb, (const bf16*)(ws + (layer ? WS_WD1 : WS_WD0)), M, DM, FFH}; pg8::StaticOrder S; S.init(M, DM, F.G, cidx);
            pg8::EpiResLN E{Yh, DM, ALPHA, STf, P.ln_mix_g + layer * DM, P.ln_mix_b + layer * DM};
            pg8::gemm_phase<pg8::EpiResLN, pg8::StaticOrder, true, true>(F.lds + RING_OFF, g, S, E);
        } PHASE_END
        GSEAM(pb + 5, GRP_SIZE);
        PHASE_BEGIN(pb + 6) { const int mb = pl ? 256 * pmg + 32 * rankg + F.wave : gwv; ln_phase(F, Yh, P.ln_ffn_g + layer * DM, P.ln_ffn_b + layer * DM, layer ? P.out : (float*)nullptr, layer ? (bf16*)nullptr : XB, layer ? (float*)nullptr : STf, mb, pl ? 256 * pmg + 32 * rankg + 32 : M, pl ? NWAVES : NGWV); } PHASE_END
        if (layer == 0) GSEAM(pb + 6, GRP_SIZE);
    }
#undef GSEAM
#undef IN
#undef PHASE_BEGIN
#undef PHASE_END
#undef SEAM
}

#if DEV_MODE
__device__ __forceinline__ int crow16(int r, int hi) { return (r & 3) + 8 * (r >> 2) + 4 * hi; }
template <bool OUT_BF16> __global__ void __launch_bounds__(256) ref_gemm(const bf16* __restrict__ A, const bf16* __restrict__ Bt, void* __restrict__ C, int M_, int N_, int K_, int ldc) {
    __shared__ __attribute__((aligned(16))) bf16 As[128 * 40];
    __shared__ __attribute__((aligned(16))) bf16 Bs[128 * 40];
    const int tid = threadIdx.x, lane = tid & 63, w = tid >> 6, wm = w >> 1, wn = w & 1, r32 = lane & 31, hi = lane >> 5;
    const int bm = blockIdx.y * 128, bn = blockIdx.x * 128;
    f32x16 acc[2][2];
#pragma unroll
    for (int a = 0; a < 2; ++a)
#pragma unroll
        for (int b = 0; b < 2; ++b)
#pragma unroll
            for (int r = 0; r < 16; ++r) acc[a][b][r] = 0.f;
    for (int k0 = 0; k0 < K_; k0 += 32) {
#pragma unroll
        for (int i = 0; i < 2; ++i) { const int idx = tid + 256 * i, row = idx >> 2, ch = idx & 3;
            *(v4u*)&As[row * 40 + ch * 8] = *(const v4u*)&A[pg8::tl_off(bm + row, k0 + ch * 8, K_)];
            *(v4u*)&Bs[row * 40 + ch * 8] = *(const v4u*)&Bt[pg8::tl_off(bn + row, k0 + ch * 8, K_)]; }
        __syncthreads();
#pragma unroll
        for (int ks = 0; ks < 2; ++ks) {
            bf16x8 a[2], b[2];
#pragma unroll
            for (int i = 0; i < 2; ++i) { a[i] = *(const bf16x8*)&As[(wm * 64 + i * 32 + r32) * 40 + ks * 16 + hi * 8]; b[i] = *(const bf16x8*)&Bs[(wn * 64 + i * 32 + r32) * 40 + ks * 16 + hi * 8]; }
#pragma unroll
            for (int mi = 0; mi < 2; ++mi)
#pragma unroll
                for (int ni = 0; ni < 2; ++ni) acc[mi][ni] = MFMA32(a[mi], b[ni], acc[mi][ni]);
        }
        __syncthreads();
    }
#pragma unroll
    for (int mi = 0; mi < 2; ++mi)
#pragma unroll
        for (int ni = 0; ni < 2; ++ni)
#pragma unroll
            for (int r = 0; r < 16; ++r) { const size_t row = bm + wm * 64 + mi * 32 + crow16(r, hi), col = bn + wn * 64 + ni * 32 + r32;
                if (OUT_BF16) ((bf16*)C)[row * ldc + col] = (bf16)f2bf(acc[mi][ni][r]); else ((float*)C)[row * ldc + col] = acc[mi][ni][r]; }
}
__global__ void __launch_bounds__(256) ref_res(const float* __restrict__ C, const bf16* __restrict__ R, bf16* __restrict__ Y, float alpha, size_t n) {
    for (size_t i = (size_t)blockIdx.x * 256 + threadIdx.x; i < n; i += (size_t)gridDim.x * 256) Y[i] = (bf16)(pk2h(alpha * h2f(R[i]) + C[i], 0.f) & 0xffffu);
}
__global__ void __launch_bounds__(256) ref_res_ln(const float* __restrict__ C, bf16* __restrict__ Y, const float* __restrict__ ST, const float* __restrict__ G, const float* __restrict__ B, float alpha, size_t n) {
    for (size_t i = (size_t)blockIdx.x * 256 + threadIdx.x; i < n; i += (size_t)gridDim.x * 256) { const size_t m = i / DM; const int c = (int)(i % DM);
        const float x = (h2f(Y[i]) - ST[2 * m]) * ST[2 * m + 1] * G[c] + B[c]; Y[i] = (bf16)(pk2h(alpha * x + C[i], 0.f) & 0xffffu); }
}
__global__ void __launch_bounds__(256) ref_swiglu(const float* __restrict__ C, bf16* __restrict__ H) {
    const size_t n = (size_t)M * FFH;
    for (size_t i = (size_t)blockIdx.x * 256 + threadIdx.x; i < n; i += (size_t)gridDim.x * 256) { const size_t m = i / FFH; const int j = (int)(i % FFH), p = j >> 7, jj = j & 127;
        const float g = C[m * NGU + 256 * p + jj], u = C[m * NGU + 256 * p + 128 + jj]; H[i] = (bf16)f2bf(g / (1.0f + expf(-g)) * u); }
}
__global__ void __launch_bounds__(256) ref_convmul(const float* __restrict__ C, bf16* __restrict__ U, bf16* __restrict__ BG) {
    const size_t n = (size_t)M * DM;
    for (size_t i = (size_t)blockIdx.x * 256 + threadIdx.x; i < n; i += (size_t)gridDim.x * 256) { const size_t m = i / DM; const int c = (int)(i % DM), p = c >> 7, cc = c & 127;
        U[i] = (bf16)f2bf(C[m * NCI + 256 * p + cc] * C[m * NCI + 256 * p + 128 + cc]); BG[i] = (bf16)f2bf(C[m * NCI + 2 * DM + c]); }
}
__global__ void __launch_bounds__(256) ref_attn(const bf16* __restrict__ QK, const bf16* __restrict__ VT, const float* __restrict__ sinks, bf16* __restrict__ O) {
    const int lane = threadIdx.x & 63, gwv = blockIdx.x * 4 + (threadIdx.x >> 6); const int m = gwv >> 5, h = gwv & 31, b = m / SEQ, s = m % SEQ, g = h >> 2;
    const bf16* q = QK + (size_t)m * NQK + h * HD;
    const float q0 = bf2f(q[lane]), q1 = bf2f(q[64 + lane]);
    float sc[2]; bool ok[2]; int pos[2];
#pragma unroll
    for (int kk = 0; kk < 2; ++kk) { pos[kk] = s - 127 + lane + 64 * kk; ok[kk] = pos[kk] >= 0; const int pp = ok[kk] ? pos[kk] : 0;
        const bf16* kr = QK + (size_t)(b * SEQ + pp) * NQK + NQ + g * HD; float dot = 0.f;
        for (int d = 0; d < 64; ++d) dot += __shfl(q0, d) * bf2f(kr[d]);
        for (int d = 0; d < 64; ++d) dot += __shfl(q1, d) * bf2f(kr[64 + d]);
        sc[kk] = ok[kk] ? dot * 0.08838834764831845f : -INFINITY; }
    const float sink = sinks[h];
    float mx = fmaxf(sc[0], sc[1]);
#pragma unroll
    for (int o = 1; o < 64; o <<= 1) mx = fmaxf(mx, __shfl_xor(mx, o));
    mx = fmaxf(mx, sink);
    const float p0 = ok[0] ? expf(sc[0] - mx) : 0.f, p1 = ok[1] ? expf(sc[1] - mx) : 0.f;
    const float denom = wave_sum(p0 + p1) + expf(sink - mx);
    float o0 = 0.f, o1 = 0.f;
    const int pp0 = ok[0] ? pos[0] : 0, pp1 = ok[1] ? pos[1] : 0;
    for (int d = 0; d < 128; ++d) { const bf16* vr = VT + (size_t)(g * HD + d) * M + (size_t)b * SEQ;
        const float part = p0 * bf2f(vr[pp0]) + p1 * bf2f(vr[pp1]); const float tot = wave_sum(part);
        if (d < 64) { if (lane == d) o0 = tot; } else { if (lane == d - 64) o1 = tot; } }
    bf16* op = O + (size_t)m * NQ + h * HD; op[lane] = (bf16)f2bf(o0 / denom); op[64 + lane] = (bf16)f2bf(o1 / denom);
}
#endif

extern "C" void kernel_launch(void* const* d_in, const int* in_sizes, int n_in, void* d_out, int out_size, void* d_ws, size_t ws_size, hipStream_t stream) {
    static int grid = 0;
    if (grid == 0) {
        if (n_in != 13 || in_sizes[0] != M * DM || out_size != M * DM || ws_size < WS_END) { fprintf(stderr, "kernel_launch: shape/workspace mismatch (n_in %d, in0 %d, out %d, ws %zu < %zu); nothing launched\n", n_in, n_in > 0 ? in_sizes[0] : -1, out_size, ws_size, (size_t)WS_END); grid = -1; return; }
        int dev = 0, cus = 0, per_cu = 0;
        if (hipGetDevice(&dev) != hipSuccess || hipDeviceGetAttribute(&cus, hipDeviceAttributeMultiprocessorCount, dev) != hipSuccess) { fprintf(stderr, "kernel_launch: device query failed\n"); grid = -1; return; }
        if (hipFuncSetAttribute((const void*)mk_fwd, hipFuncAttributeMaxDynamicSharedMemorySize, LDS_BYTES) != hipSuccess) { fprintf(stderr, "kernel_launch: hipFuncSetAttribute failed\n"); grid = -1; return; }
        if (hipOccupancyMaxActiveBlocksPerMultiprocessor(&per_cu, (const void*)mk_fwd, NWAVES * 64, LDS_BYTES) != hipSuccess || per_cu < 1) fprintf(stderr, "kernel_launch: note: occupancy query reports %d workgroups per CU\n", per_cu);
        (void)hipGetLastError();
        grid = cus;
    }
    if (grid < 0) return;
    if (hipMemsetAsync((char*)d_ws + WS_CTL, 0, CTL_ZERO_BYTES, stream) != hipSuccess) { fprintf(stderr, "kernel_launch: memset failed\n"); return; }
    Args a{};
    for (int i = 0; i < 13; ++i) a.in[i] = (const float*)d_in[i];
    a.out = (float*)d_out; a.ws = (unsigned char*)d_ws;
#if !DEV_MODE
    a.ph_lo = 0; a.ph_hi = NPHASE; a.use_bar = 1;
    hipLaunchKernelGGL(mk_fwd, dim3(grid), dim3(NWAVES * 64), LDS_BYTES, stream, a);
    { const hipError_t le = hipPeekAtLastError(); if (le != hipSuccess) fprintf(stderr, "kernel_launch: launch failed: %s\n", hipGetErrorName(le)); }
#else
    unsigned char* ws = (unsigned char*)d_ws;
    bf16* XB = (bf16*)(ws + WS_XB); bf16* QKb = (bf16*)(ws + WS_QK); bf16* VTb = (bf16*)(ws + WS_VT); bf16* Ob = (bf16*)(ws + WS_O); bf16* Yh = (bf16*)(ws + WS_Y); bf16* XH = (bf16*)(ws + WS_X); float* STf = (float*)(ws + WS_ST);
    bf16* Hb = (bf16*)(ws + WS_H); bf16* Ub = (bf16*)(ws + WS_U); bf16* BGb = (bf16*)(ws + WS_BG); float* Cf = (float*)(ws + WS_C);
    for (int p = 0; p < NPHASE; ++p) {
        const int layer = p >= 8 ? 1 : 0, q = p == 0 ? -1 : (p - 1) % 7;
        const bool shared = (p == 0) || q == 3 || q == 6 || p == 9;
        if (shared || ((FASTMASK >> p) & 1u)) { a.ph_lo = p; a.ph_hi = p + 1; a.use_bar = 0; hipLaunchKernelGGL(mk_fwd, dim3(grid), dim3(NWAVES * 64), LDS_BYTES, stream, a); continue; }
        if (p == 1) { hipLaunchKernelGGL(ref_gemm<true>, dim3(NQK / 128, M / 128), dim3(256), 0, stream, XB, (const bf16*)(ws + WS_WQKV), (void*)QKb, M, NQK, DM, NQK);
                      hipLaunchKernelGGL(ref_gemm<true>, dim3(M / 128, NKV / 128), dim3(256), 0, stream, (const bf16*)(ws + WS_WV), XB, (void*)VTb, NKV, M, DM, M); }
        else if (p == 2) hipLaunchKernelGGL(ref_attn, dim3(M * NHEAD / 4), dim3(256), 0, stream, QKb, VTb, (const float*)d_in[2], Ob);
        else if (p == 8) { hipLaunchKernelGGL(ref_gemm<false>, dim3(NCI / 128, M / 128), dim3(256), 0, stream, XB, (const bf16*)(ws + WS_WCI), (void*)Cf, M, NCI, DM, NCI);
                           hipLaunchKernelGGL(ref_convmul, dim3(4096), dim3(256), 0, stream, Cf, Ub, BGb); }
        else if (q == 2) { hipLaunchKernelGGL(ref_gemm<false>, dim3(DM / 128, M / 128), dim3(256), 0, stream, Ob, (const bf16*)(ws + (layer ? WS_WCO : WS_WO)), (void*)Cf, M, DM, DM, DM);
                           if (layer == 0) hipLaunchKernelGGL(ref_res, dim3(4096), dim3(256), 0, stream, Cf, (const bf16*)XH, Yh, ALPHA, (size_t)M * DM);
                           else hipLaunchKernelGGL(ref_res_ln, dim3(4096), dim3(256), 0, stream, Cf, Yh, (const float*)STf, (const float*)d_in[11], (const float*)d_in[12], ALPHA, (size_t)M * DM); }
        else if (q == 4) { hipLaunchKernelGGL(ref_gemm<false>, dim3(NGU / 128, M / 128), dim3(256), 0, stream, XB, (const bf16*)(ws + (layer ? WS_WGU1 : WS_WGU0)), (void*)Cf, M, NGU, DM, NGU);
                           hipLaunchKernelGGL(ref_swiglu, dim3(8192), dim3(256), 0, stream, Cf, Hb); }
        else if (q == 5) { hipLaunchKernelGGL(ref_gemm<false>, dim3(DM / 128, M / 128), dim3(256), 0, stream, Hb, (const bf16*)(ws + (layer ? WS_WD1 : WS_WD0)), (void*)Cf, M, DM, FFH, DM);
                           hipLaunchKernelGGL(ref_res_ln, dim3(4096), dim3(256), 0, stream, Cf, Yh, (const float*)STf, (const float*)d_in[7] + layer * DM, (const float*)d_in[8] + layer * DM, ALPHA, (size_t)M * DM); }
    }
    { const hipError_t le = hipPeekAtLastError(); if (le != hipSuccess) fprintf(stderr, "kernel_launch: a launch failed: %s\n", hipGetErrorName(le)); }
#endif
}
```

```cpp
#include <hip/hip_runtime.h>
#include <cstdio>
#include <cstdint>
#include <cmath>

#ifndef DEV_MODE
#define DEV_MODE 0
#endif
#ifndef FASTMASK
#define FASTMASK 0x7fffu
#endif

namespace pg8 {
#define PG8_LAS __attribute__((address_space(3)))
typedef unsigned short bf16_t;
typedef short bf16x8 __attribute__((ext_vector_type(8)));
typedef float f32x4 __attribute__((ext_vector_type(4)));
typedef unsigned u32x4 __attribute__((ext_vector_type(4)));
typedef int i32x4 __attribute__((ext_vector_type(4)));
typedef int i32x8 __attribute__((ext_vector_type(8)));
__device__ __forceinline__ i32x8 cat8(bf16x8 lo, bf16x8 hi) { const i32x4 a = __builtin_bit_cast(i32x4, lo), b = __builtin_bit_cast(i32x4, hi); return __builtin_shufflevector(a, b, 0, 1, 2, 3, 4, 5, 6, 7); }
__device__ __forceinline__ void mfma8(f32x4& c, const i32x8 a, const i32x8 b, int one) {
    asm volatile("v_mfma_scale_f32_16x16x128_f8f6f4 %0, %1, %2, %0, %3, %3 op_sel_hi:[0,0,0]" : "+v"(c) : "v"(a), "v"(b), "v"(one));
}
constexpr int BM = 256, BK = 64, HALF = 128, HTB = HALF * BK * 2  , STAGE_BYTES = 8 * HTB, NXCD = 8, WGM = 4;

__host__ __device__ __forceinline__ int lds_byte(int r, int c) { const int st = (r >> 4) * 2 + (c >> 5), rr = r & 15, cc = c & 31, ob = rr * 64 + cc * 2; return st * 1024 + (ob ^ (((ob >> 9) & 1) << 5)); }
__host__ __device__ __forceinline__ void stage_rc(int b, int& R, int& C) { const int st = b / 1024, sb = b % 1024, swz = sb ^ (((sb >> 9) & 1) << 5); R = (st >> 1) * 16 + swz / 64; C = (st & 1) * 32 + (swz % 64) / 2; }
__host__ __device__ __forceinline__ int perm32(int rho) { const int n = rho >> 4, i = rho & 15; return 8 * (i >> 2) + 4 * n + (i & 3); }

__host__ __device__ __forceinline__ size_t tl_off(int row, int k, int K) { return ((size_t)(row >> 8) * (size_t)(K >> 6) + (size_t)(k >> 6)) * 16384 + (size_t)(((row >> 7) & 1) * 8192 + (lds_byte(row & 127, k & 63) >> 1)); }
__host__ __device__ __forceinline__ int pinv32(int w) { return 16 * ((w >> 2) & 1) + 4 * (w >> 3) + (w & 3); }
__host__ __device__ __forceinline__ size_t tl_off_w(int row, int k, int K) { return tl_off((row & ~31) + pinv32(row & 31), k, K); }
struct Unit { int pm, pn; };
struct Gemm { const bf16_t* A; const bf16_t* Bt; int M, N, K; int bnat = 0; };

struct StaticOrder {
    int nM, nN, nwg, G, c;
    __host__ __device__ void init(int M, int N, int G_, int c_) { nM = M / BM; nN = N / BM; nwg = nM * nN; G = G_; c = c_; }
    __host__ __device__ bool next(int i, Unit& u) const {
        const long L = (long)i * G + c; if (L >= nwg) return false;
        int wgid = (int)L; { const int q = nwg / NXCD, r = nwg % NXCD, xcd = wgid % NXCD, off = wgid / NXCD; wgid = (xcd < r ? xcd * (q + 1) : r * (q + 1) + (xcd - r) * q) + off; }
        const int nig = WGM * nN, gid = wgid / nig, fm = gid * WGM, gsz = (nM - fm) < WGM ? (nM - fm) : WGM;
        u.pm = fm + ((wgid % nig) % gsz); u.pn = (wgid % nig) / gsz; return true;
    }
    __device__ __forceinline__ void a_ready(const Unit&) const {}
    __device__ __forceinline__ void done(const Unit&) const {}
};

__device__ __forceinline__ unsigned cvt_pk_bf16(float lo, float hi) { unsigned r; asm volatile("v_cvt_pk_bf16_f32 %0, %1, %2" : "=v"(r) : "v"(lo), "v"(hi)); return r; }
typedef unsigned u32x2 __attribute__((ext_vector_type(2)));
typedef float f32x2 __attribute__((ext_vector_type(2)));
constexpr float LOG2E_F = 1.4426950408889634f;
__device__ __forceinline__ float silu_f(float g) { return g * __builtin_amdgcn_rcpf(1.0f + __builtin_amdgcn_exp2f(-g * LOG2E_F)); }

struct EpiBf16 {
    static constexpr bool PERM = true, AFTER_DRAIN = false;
    bf16_t* O; int ldc; float sc; const float* ts; int tcol;
    __device__ __forceinline__ void operator()(const f32x4 (&acc)[2][2][4][2], const Unit& u, int wr, int wc, int fr, int fq) const {
        typedef const __attribute__((address_space(1))) float gcf_t; typedef const __attribute__((address_space(1))) f32x4 gcf4_t;
        const int row0 = u.pm * BM + wr * 64 + fr, col0 = u.pn * BM + wc * 32 + 8 * fq;
        f32x4 c0[2], c1[2];
#pragma unroll
        for (int bj = 0; bj < 2; ++bj) { c0[bj] = (f32x4){sc, sc, sc, sc}; c1[bj] = c0[bj]; if (ts && tcol) { c0[bj] = *(gcf4_t*)(ts + col0 + bj * HALF) * sc; c1[bj] = *(gcf4_t*)(ts + col0 + bj * HALF + 4) * sc; } }
#pragma unroll
        for (int ai = 0; ai < 2; ++ai)
#pragma unroll
            for (int m = 0; m < 4; ++m) { bf16_t* rowp = O + (size_t)(row0 + ai * HALF + m * 16) * ldc + col0;
                const float r = (ts && !tcol) ? ((gcf_t*)ts)[row0 + ai * HALF + m * 16] : 1.f;
#pragma unroll
                for (int bj = 0; bj < 2; ++bj) { const f32x4 v0 = acc[ai][bj][m][0] * c0[bj] * r, v1 = acc[ai][bj][m][1] * c1[bj] * r;
                    u32x4 w; w.x = cvt_pk_bf16(v0[0], v0[1]); w.y = cvt_pk_bf16(v0[2], v0[3]); w.z = cvt_pk_bf16(v1[0], v1[1]); w.w = cvt_pk_bf16(v1[2], v1[3]);
                    *(u32x4*)(rowp + bj * HALF) = w; } }
    }
};
struct EpiSwiGLU {
    static constexpr bool PERM = true, AFTER_DRAIN = false;
    bf16_t* H; int ldh; float sc; int pn0; const float* rs;
    __device__ __forceinline__ void operator()(const f32x4 (&acc)[2][2][4][2], const Unit& u, int wr, int wc, int fr, int fq) const {
        const int row0 = u.pm * BM + wr * 64 + fr, col0 = (u.pn + pn0) * HALF + wc * 32 + 8 * fq;
#pragma unroll
        for (int ai = 0; ai < 2; ++ai)
#pragma unroll
            for (int m = 0; m < 4; ++m) { bf16_t* rowp = H + tl_off(row0 + ai * HALF + m * 16, col0, ldh);
                const float rsc = rs ? sc * ((const __attribute__((address_space(1))) float*)rs)[row0 + ai * HALF + m * 16] : sc;
                const f32x4 g0 = acc[ai][0][m][0] * rsc, g1 = acc[ai][0][m][1] * rsc, u0 = acc[ai][1][m][0] * rsc, u1 = acc[ai][1][m][1] * rsc;
                u32x4 w;
                w.x = cvt_pk_bf16(silu_f(g0[0]) * u0[0], silu_f(g0[1]) * u0[1]); w.y = cvt_pk_bf16(silu_f(g0[2]) * u0[2], silu_f(g0[3]) * u0[3]);
                w.z = cvt_pk_bf16(silu_f(g1[0]) * u1[0], silu_f(g1[1]) * u1[1]); w.w = cvt_pk_bf16(silu_f(g1[2]) * u1[2], silu_f(g1[3]) * u1[3]);
                __builtin_nontemporal_store(w, (u32x4*)rowp); }
    }
};
struct EpiConvIn {
    static constexpr bool PERM = true, AFTER_DRAIN = false;
    bf16_t* U; bf16_t* BG; int ld; int npair;
    __device__ __forceinline__ void operator()(const f32x4 (&acc)[2][2][4][2], const Unit& u, int wr, int wc, int fr, int fq) const {
        const int row0 = u.pm * BM + wr * 64 + fr;
        if (u.pn < npair) {
            const int col0 = u.pn * HALF + wc * 32 + 8 * fq;
#pragma unroll
            for (int ai = 0; ai < 2; ++ai)
#pragma unroll
                for (int m = 0; m < 4; ++m) { bf16_t* rowp = U + (size_t)(row0 + ai * HALF + m * 16) * ld + col0;
                    const f32x4 v0 = acc[ai][0][m][0] * acc[ai][1][m][0], v1 = acc[ai][0][m][1] * acc[ai][1][m][1];
                    u32x4 w; w.x = cvt_pk_bf16(v0[0], v0[1]); w.y = cvt_pk_bf16(v0[2], v0[3]); w.z = cvt_pk_bf16(v1[0], v1[1]); w.w = cvt_pk_bf16(v1[2], v1[3]);
                    *(u32x4*)rowp = w; }
        } else {
            const int col0 = (u.pn - npair) * BM + wc * 32 + 8 * fq;
#pragma unroll
            for (int ai = 0; ai < 2; ++ai)
#pragma unroll
                for (int m = 0; m < 4; ++m) { bf16_t* rowp = BG + (size_t)(row0 + ai * HALF + m * 16) * ld + col0;
#pragma unroll
                    for (int bj = 0; bj < 2; ++bj) { const f32x4 v0 = acc[ai][bj][m][0], v1 = acc[ai][bj][m][1];
                        u32x4 w; w.x = cvt_pk_bf16(v0[0], v0[1]); w.y = cvt_pk_bf16(v0[2], v0[3]); w.z = cvt_pk_bf16(v1[0], v1[1]); w.w = cvt_pk_bf16(v1[2], v1[3]);
                        *(u32x4*)(rowp + bj * HALF) = w; } }
        }
    }
};
typedef _Float16 f16x8 __attribute__((ext_vector_type(8)));
__device__ __forceinline__ unsigned cvt_pk_f16(float lo, float hi) { unsigned r; asm volatile("v_cvt_pk_f16_f32 %0, %1, %2" : "=v"(r) : "v"(lo), "v"(hi)); return r; }
struct EpiResF16 {
    static constexpr bool PERM = true, AFTER_DRAIN = false;
    const bf16_t* R; bf16_t* Y; int ldc; float alpha, asc;
    __device__ __forceinline__ void operator()(const f32x4 (&acc)[2][2][4][2], const Unit& u, int wr, int wc, int fr, int fq) const {
        const int row0 = u.pm * BM + wr * 64 + fr, col0 = u.pn * BM + wc * 32 + 8 * fq;
#pragma unroll
        for (int ai = 0; ai < 2; ++ai) {
            u32x4 rv[4][2];
#pragma unroll
            for (int m = 0; m < 4; ++m)
#pragma unroll
                for (int bj = 0; bj < 2; ++bj) rv[m][bj] = *(const u32x4*)(R + (size_t)(row0 + ai * HALF + m * 16) * ldc + col0 + bj * HALF);
#pragma unroll
            for (int m = 0; m < 4; ++m)
#pragma unroll
                for (int bj = 0; bj < 2; ++bj) { const f16x8 hr = __builtin_bit_cast(f16x8, rv[m][bj]);
                    const f32x4 a0 = acc[ai][bj][m][0] * asc, a1 = acc[ai][bj][m][1] * asc; u32x4 w;
                    w.x = cvt_pk_f16((float)hr[0] * alpha + a0[0], (float)hr[1] * alpha + a0[1]);
                    w.y = cvt_pk_f16((float)hr[2] * alpha + a0[2], (float)hr[3] * alpha + a0[3]);
                    w.z = cvt_pk_f16((float)hr[4] * alpha + a1[0], (float)hr[5] * alpha + a1[1]);
                    w.w = cvt_pk_f16((float)hr[6] * alpha + a1[2], (float)hr[7] * alpha + a1[3]);
                    *(u32x4*)(Y + (size_t)(row0 + ai * HALF + m * 16) * ldc + col0 + bj * HALF) = w; }
            asm volatile("" ::: "memory"); }
    }
};

struct EpiResLN {
    static constexpr bool PERM = true, AFTER_DRAIN = false;
    bf16_t* Y; int ldc; float alpha; const float* ST; const float* G; const float* B;
    __device__ __forceinline__ void operator()(const f32x4 (&acc)[2][2][4][2], const Unit& u, int wr, int wc, int fr, int fq) const {
        asm volatile("" ::: "memory");
        int fr_ = fr, fq_ = fq; asm volatile("" : "+v"(fr_), "+v"(fq_));
        const int row0 = u.pm * BM + wr * 64 + fr_, col0 = u.pn * BM + wc * 32 + 8 * fq_;
        typedef __attribute__((address_space(1))) const float gcf; typedef __attribute__((address_space(1))) const f32x4 gcf4; typedef __attribute__((address_space(1))) const f32x2 gcf2;
        gcf* Gg = (gcf*)G; gcf* Bg = (gcf*)B; gcf* STg = (gcf*)ST;
        f32x4 ga[2][2], ba[2][2];
#pragma unroll
        for (int bj = 0; bj < 2; ++bj)
#pragma unroll
            for (int n = 0; n < 2; ++n) { ga[bj][n] = *(gcf4*)(Gg + col0 + bj * HALF + 4 * n) * alpha; ba[bj][n] = *(gcf4*)(Bg + col0 + bj * HALF + 4 * n) * alpha; }
#pragma unroll
        for (int ai = 0; ai < 2; ++ai) {
            u32x4 rv[4][2]; f32x2 st[4];
#pragma unroll
            for (int m = 0; m < 4; ++m) { st[m] = *(gcf2*)(STg + 2 * (size_t)(row0 + ai * HALF + m * 16));
#pragma unroll
                for (int bj = 0; bj < 2; ++bj) rv[m][bj] = *(const u32x4*)(Y + (size_t)(row0 + ai * HALF + m * 16) * ldc + col0 + bj * HALF); }
#pragma unroll
            for (int m = 0; m < 4; ++m)
#pragma unroll
                for (int bj = 0; bj < 2; ++bj) { const f16x8 hr = __builtin_bit_cast(f16x8, rv[m][bj]); const float mu = st[m].x, rs = st[m].y;
                    const f32x4 a0 = acc[ai][bj][m][0], a1 = acc[ai][bj][m][1], g0 = ga[bj][0], g1 = ga[bj][1], b0 = ba[bj][0], b1 = ba[bj][1]; u32x4 w;
                    w.x = cvt_pk_f16(((float)hr[0] - mu) * rs * g0[0] + (b0[0] + a0[0]), ((float)hr[1] - mu) * rs * g0[1] + (b0[1] + a0[1]));
                    w.y = cvt_pk_f16(((float)hr[2] - mu) * rs * g0[2] + (b0[2] + a0[2]), ((float)hr[3] - mu) * rs * g0[3] + (b0[3] + a0[3]));
                    w.z = cvt_pk_f16(((float)hr[4] - mu) * rs * g1[0] + (b1[0] + a1[0]), ((float)hr[5] - mu) * rs * g1[1] + (b1[1] + a1[1]));
                    w.w = cvt_pk_f16(((float)hr[6] - mu) * rs * g1[2] + (b1[2] + a1[2]), ((float)hr[7] - mu) * rs * g1[3] + (b1[3] + a1[3]));
                    *(u32x4*)(Y + (size_t)(row0 + ai * HALF + m * 16) * ldc + col0 + bj * HALF) = w; }
            asm volatile("" ::: "memory"); }
    }
};

template <class Epi, class Sched, bool ALIGN_EPI = false, bool SP2 = false, bool F8 = false, bool I8 = false>
__device__ __forceinline__ void gemm_phase(PG8_LAS unsigned char* lds, const Gemm g, const Sched& S, const Epi& E) {
    int tid_ = threadIdx.x; asm volatile("" : "+v"(tid_));
    const int tid = tid_, wid = __builtin_amdgcn_readfirstlane(tid >> 6), lane = tid & 63, wr = wid >> 2, wc = wid & 3, fr = lane & 15, fq = lane >> 4;
    const int K = g.K, nt = K / BK;
    int f8one = 0x7F7F7F7F; if constexpr (F8) asm volatile("" : "+v"(f8one));
    unsigned voffA[2], voffB[2];
#pragma unroll
    for (int i = 0; i < 2; ++i) { const int b = tid * 16 + i * 8192; int R, C; stage_rc(b, R, C); const int Rb = Epi::PERM ? ((R & ~31) + perm32(R & 31)) : R;
        voffA[i] = (unsigned)b; voffB[i] = g.bnat ? (unsigned)lds_byte(Rb, C) : (unsigned)b; }
    const size_t kstep = (size_t)BM * BK * 2;
    const size_t hstep = (size_t)HALF * BK * 2;
    const size_t tstep = (size_t)BM * K * 2;
    const unsigned ldsw = (unsigned)wid * 1024u;
    const int aoff = lds_byte(wr * 64 + fr, fq * 8), boff = lds_byte(wc * 32 + fr, fq * 8);
#define PG8_SA(b, h) (((b) * 2 + (h)) * HTB)
#define PG8_SB(b, h) ((4 + (b) * 2 + (h)) * HTB)
#define PG8_STAGE(bufoff, gbase, voff) do { _Pragma("unroll") for (int _i = 0; _i < 2; ++_i) \
        __builtin_amdgcn_global_load_lds((const unsigned*)((const char*)(gbase) + (voff)[_i]), (PG8_LAS unsigned*)(lds + (bufoff) + ldsw + _i * 8192), 16, 0, 0); } while (0)
#define PG8_LDA(dst, b, h) do { _Pragma("unroll") for (int m = 0; m < 4; ++m) _Pragma("unroll") for (int k = 0; k < 2; ++k) dst[m][k] = *(const PG8_LAS bf16x8*)(lds + PG8_SA(b, h) + aoff + m * 2048 + k * 1024); } while (0)
#define PG8_LDB(dst, b, h) do { _Pragma("unroll") for (int n = 0; n < 2; ++n) _Pragma("unroll") for (int k = 0; k < 2; ++k) dst[n][k] = *(const PG8_LAS bf16x8*)(lds + PG8_SB(b, h) + boff + n * 2048 + k * 1024); } while (0)
#define PG8_MMA(ai, bj, At, Bt) do { __builtin_amdgcn_s_setprio(1); \
        if constexpr (F8) { _Pragma("unroll") for (int m = 0; m < 4; ++m) _Pragma("unroll") for (int n = 0; n < 2; ++n) mfma8(acc[ai][bj][m][n], cat8(Bt[n][0], Bt[n][1]), cat8(At[m][0], At[m][1]), f8one); } \
        else if constexpr (I8) { _Pragma("unroll") for (int m = 0; m < 4; ++m) _Pragma("unroll") for (int n = 0; n < 2; ++n) _Pragma("unroll") for (int k = 0; k < 2; ++k) \
            acc[ai][bj][m][n] = __builtin_bit_cast(f32x4, __builtin_amdgcn_mfma_i32_16x16x64_i8(__builtin_bit_cast(i32x4, Bt[n][k]), __builtin_bit_cast(i32x4, At[m][k]), __builtin_bit_cast(i32x4, acc[ai][bj][m][n]), 0, 0, 0)); } \
        else { _Pragma("unroll") for (int m = 0; m < 4; ++m) _Pragma("unroll") for (int n = 0; n < 2; ++n) _Pragma("unroll") for (int k = 0; k < 2; ++k) \
            acc[ai][bj][m][n] = __builtin_amdgcn_mfma_f32_16x16x32_bf16(Bt[n][k], At[m][k], acc[ai][bj][m][n], 0, 0, 0); } \
        __builtin_amdgcn_s_setprio(0); } while (0)
#define PG8_WAIT_V(n) asm volatile("s_waitcnt vmcnt(" #n ")" ::: "memory")
#define PG8_WAIT_L(n) asm volatile("s_waitcnt lgkmcnt(" #n ")" ::: "memory")
#define PG8_BAR __builtin_amdgcn_s_barrier()
#define PG8_SCHED __builtin_amdgcn_sched_barrier(0)
    Unit cur, nxt; int ui = 0;
    if (!S.next(0, cur)) return;
    f32x4 acc[2][2][4][2];
#pragma unroll
    for (int a = 0; a < 2; ++a)
#pragma unroll
        for (int b = 0; b < 2; ++b)
#pragma unroll
            for (int m = 0; m < 4; ++m)
#pragma unroll
                for (int n = 0; n < 2; ++n) acc[a][b][m][n] = (f32x4){0.f, 0.f, 0.f, 0.f};
    bf16x8 At[4][2], B0[2][2], B1[2][2];
    const char* cA = (const char*)g.A + (size_t)cur.pm * tstep; const char* cB = (const char*)g.Bt + (size_t)cur.pn * tstep;
    S.a_ready(cur);
    if constexpr (SP2) {
        PG8_STAGE(PG8_SB(0, 0), cB, voffB); PG8_STAGE(PG8_SB(0, 1), cB + hstep, voffB); PG8_STAGE(PG8_SA(0, 0), cA, voffA); PG8_STAGE(PG8_SA(0, 1), cA + hstep, voffA);
        if (wr == 1) PG8_BAR;
        PG8_WAIT_V(2); PG8_BAR;
        PG8_STAGE(PG8_SB(1, 0), cB + kstep, voffB); PG8_STAGE(PG8_SA(1, 0), cA + kstep, voffA); PG8_STAGE(PG8_SB(1, 1), cB + hstep + kstep, voffB);
        PG8_WAIT_V(6); PG8_BAR;
    } else {
        PG8_STAGE(PG8_SB(0, 0), cB, voffB); PG8_STAGE(PG8_SA(0, 0), cA, voffA); PG8_STAGE(PG8_SB(0, 1), cB + hstep, voffB); PG8_STAGE(PG8_SA(0, 1), cA + hstep, voffA);
        if (wr == 1) PG8_BAR;
        PG8_WAIT_V(4); PG8_BAR;
        PG8_STAGE(PG8_SB(1, 0), cB + kstep, voffB); PG8_STAGE(PG8_SA(1, 0), cA + kstep, voffA); PG8_STAGE(PG8_SB(1, 1), cB + hstep + kstep, voffB);
        PG8_WAIT_V(6); PG8_BAR;
    }
    for (;;) {
        const bool has_next = S.next(ui + 1, nxt);
        const char* nA = has_next ? (const char*)g.A + (size_t)nxt.pm * tstep : cA; const char* nB = has_next ? (const char*)g.Bt + (size_t)nxt.pn * tstep : cB;
        for (int t = 0; t < nt; t += 2) {
            const bool last = (t == nt - 2);
            const char* a1 = cA + (size_t)(t + 1) * kstep;
            const char* a2 = last ? nA : cA + (size_t)(t + 2) * kstep; const char* b2 = last ? nB : cB + (size_t)(t + 2) * kstep;
            const char* a3 = a2 + kstep; const char* b3 = b2 + kstep;
            if (last && has_next) S.a_ready(nxt);
            if constexpr (SP2) {
            PG8_LDB(B0, 0, 0); PG8_LDB(B1, 0, 1); PG8_SCHED; PG8_LDA(At, 0, 0); PG8_STAGE(PG8_SA(1, 1), a1 + hstep, voffA);
            PG8_WAIT_V(8); PG8_WAIT_L(0); PG8_BAR; PG8_MMA(0, 0, At, B0); PG8_MMA(0, 1, At, B1); PG8_BAR; PG8_SCHED;
            PG8_LDA(At, 0, 1); PG8_STAGE(PG8_SB(0, 0), b2, voffB); PG8_STAGE(PG8_SB(0, 1), b2 + hstep, voffB); PG8_STAGE(PG8_SA(0, 0), a2, voffA);
            PG8_WAIT_V(8); PG8_WAIT_L(0); PG8_BAR; PG8_MMA(1, 0, At, B0); PG8_MMA(1, 1, At, B1); PG8_BAR; PG8_SCHED;
            PG8_LDB(B0, 1, 0); PG8_LDB(B1, 1, 1); PG8_SCHED; PG8_LDA(At, 1, 0); PG8_STAGE(PG8_SA(0, 1), a2 + hstep, voffA);
            PG8_WAIT_V(8); PG8_WAIT_L(0); PG8_BAR; PG8_MMA(0, 0, At, B0); PG8_MMA(0, 1, At, B1); PG8_BAR; PG8_SCHED;
            PG8_LDA(At, 1, 1); PG8_STAGE(PG8_SB(1, 0), b3, voffB); PG8_STAGE(PG8_SB(1, 1), b3 + hstep, voffB); PG8_STAGE(PG8_SA(1, 0), a3, voffA);
            PG8_WAIT_V(8); PG8_WAIT_L(0); PG8_BAR; PG8_MMA(1, 0, At, B0); PG8_MMA(1, 1, At, B1); PG8_BAR; PG8_SCHED;
            } else {
            PG8_LDB(B0, 0, 0); PG8_SCHED; PG8_LDA(At, 0, 0); PG8_STAGE(PG8_SA(1, 1), a1 + hstep, voffA);
            PG8_WAIT_L(8); PG8_BAR; PG8_WAIT_L(0); PG8_MMA(0, 0, At, B0); PG8_BAR; PG8_SCHED;
            PG8_LDB(B1, 0, 1); PG8_STAGE(PG8_SB(0, 0), b2, voffB);
            PG8_BAR; PG8_WAIT_L(0); PG8_MMA(0, 1, At, B1); PG8_BAR;
            PG8_LDA(At, 0, 1); PG8_STAGE(PG8_SA(0, 0), a2, voffA);
            PG8_BAR; PG8_WAIT_L(0); PG8_MMA(1, 0, At, B0); PG8_BAR; PG8_SCHED;
            PG8_STAGE(PG8_SB(0, 1), b2 + hstep, voffB);
            PG8_WAIT_V(6); PG8_BAR; PG8_MMA(1, 1, At, B1); PG8_BAR;
            PG8_LDB(B0, 1, 0); PG8_SCHED; PG8_LDA(At, 1, 0); PG8_STAGE(PG8_SA(0, 1), a2 + hstep, voffA);
            PG8_WAIT_L(8); PG8_BAR; PG8_WAIT_L(0); PG8_MMA(0, 0, At, B0); PG8_BAR; PG8_SCHED;
            PG8_LDB(B1, 1, 1); PG8_STAGE(PG8_SB(1, 0), b3, voffB);
            PG8_BAR; PG8_WAIT_L(0); PG8_MMA(0, 1, At, B1); PG8_BAR;
            PG8_LDA(At, 1, 1); PG8_STAGE(PG8_SA(1, 0), a3, voffA);
            PG8_BAR; PG8_WAIT_L(0); PG8_MMA(1, 0, At, B0); PG8_BAR; PG8_SCHED;
            PG8_STAGE(PG8_SB(1, 1), b3 + hstep, voffB);
            PG8_WAIT_V(6); PG8_BAR; PG8_MMA(1, 1, At, B1); PG8_BAR;
            }
        }
        if constexpr (ALIGN_EPI) { if (wr == 0) PG8_BAR; }
        if constexpr (F8) asm volatile("s_nop 15\n\ts_nop 15"
            : "+v"(acc[1][0][0][0]), "+v"(acc[1][0][0][1]), "+v"(acc[1][0][1][0]), "+v"(acc[1][0][1][1]), "+v"(acc[1][0][2][0]), "+v"(acc[1][0][2][1]), "+v"(acc[1][0][3][0]), "+v"(acc[1][0][3][1]),
              "+v"(acc[1][1][0][0]), "+v"(acc[1][1][0][1]), "+v"(acc[1][1][1][0]), "+v"(acc[1][1][1][1]), "+v"(acc[1][1][2][0]), "+v"(acc[1][1][2][1]), "+v"(acc[1][1][3][0]), "+v"(acc[1][1][3][1]) :: "memory");
        if constexpr (I8) {
#pragma unroll
            for (int a = 0; a < 2; ++a)
#pragma unroll
                for (int b = 0; b < 2; ++b)
#pragma unroll
                    for (int m = 0; m < 4; ++m)
#pragma unroll
                        for (int n = 0; n < 2; ++n) acc[a][b][m][n] = __builtin_convertvector(__builtin_bit_cast(i32x4, acc[a][b][m][n]), f32x4); }
        if constexpr (!Epi::AFTER_DRAIN) { E(acc, cur, wr, wc, fr, fq); S.done(cur); }
        if (!has_next) break;
#pragma unroll
        for (int a = 0; a < 2; ++a)
#pragma unroll
            for (int b = 0; b < 2; ++b)
#pragma unroll
                for (int m = 0; m < 4; ++m)
#pragma unroll
                    for (int n = 0; n < 2; ++n) acc[a][b][m][n] = (f32x4){0.f, 0.f, 0.f, 0.f};
        cur = nxt; cA = nA; cB = nB; ++ui;
        if constexpr (ALIGN_EPI) { if (wr == 1) PG8_BAR; }
    }
    PG8_WAIT_V(0);
    if constexpr (!ALIGN_EPI) { if (wr == 0) PG8_BAR; }
    PG8_BAR;
    if constexpr (Epi::AFTER_DRAIN) { E.fused(acc, cur, wr, wc, fr, fq, lds, wid, lane); S.done(cur); }
#undef PG8_SA
#undef PG8_SB
#undef PG8_STAGE
#undef PG8_LDA
#undef PG8_LDB
#undef PG8_MMA
#undef PG8_WAIT_V
#undef PG8_WAIT_L
#undef PG8_BAR
#undef PG8_SCHED
}
}

constexpr int NWAVES = 8;
constexpr int BATCH = 2, SEQ = 4096, DM = 4096, M = BATCH * SEQ;
constexpr int NHEAD = 32, NKVH = 8, HD = 128, NQ = 4096, NKV = 1024, NQK = NQ + NKV, NQKV = NQ + 2 * NKV;
constexpr int FFH = 11008, NGU = 2 * FFH, NCI = 3 * DM;
constexpr float ALPHA = 1.4142135623730951f;
constexpr float LN_EPS = 1e-5f;
constexpr int NPHASE = 15;

constexpr size_t MiB = 1u << 20;
constexpr size_t WS_CTL = 0, CTL_ZERO_BYTES = 1 * MiB;
constexpr size_t WS_WQKV = 2 * MiB;
constexpr size_t WS_WV = WS_WQKV + (size_t)NQK * DM * 2;
constexpr size_t WS_WO = 50 * MiB;
constexpr size_t WS_WCI = 82 * MiB;
constexpr size_t WS_WCO = 178 * MiB;
constexpr size_t WS_WGU0 = 210 * MiB, WS_WGU1 = 382 * MiB;
constexpr size_t WS_WD0 = 554 * MiB, WS_WD1 = 640 * MiB;
constexpr size_t WS_XB = 726 * MiB;
constexpr size_t WS_QK = 790 * MiB;
constexpr size_t WS_VT = 870 * MiB;
constexpr size_t WS_O = 886 * MiB;
constexpr size_t WS_Y = 950 * MiB;
constexpr size_t WS_X = 1078 * MiB;
constexpr size_t WS_ST = WS_X + 64 * MiB;
constexpr size_t WS_H = 1206 * MiB;
constexpr size_t WS_U = 1378 * MiB, WS_BG = 1442 * MiB;
constexpr size_t WS_C = 1506 * MiB;
constexpr size_t WS_XB8 = WS_C;
constexpr size_t WS_WGU8 = WS_C + 64 * MiB;
constexpr size_t WS_RS = WS_C + 400 * MiB;
constexpr size_t WS_RSX = WS_RS + 1 * MiB;
constexpr size_t WS_END = 2194 * MiB;
static_assert(WS_WV + (size_t)NKV * DM * 2 == WS_WO && WS_WO + (size_t)DM * DM * 2 == WS_WCI && WS_WCI + (size_t)NCI * DM * 2 == WS_WCO && WS_WCO + (size_t)DM * DM * 2 == WS_WGU0, "ws map 1");
static_assert(WS_WGU0 + (size_t)NGU * DM * 2 == WS_WGU1 && WS_WGU1 + (size_t)NGU * DM * 2 == WS_WD0 && WS_WD0 + (size_t)DM * FFH * 2 == WS_WD1 && WS_WD1 + (size_t)DM * FFH * 2 == WS_XB, "ws map 2");
static_assert(WS_XB + (size_t)M * DM * 2 == WS_QK && WS_QK + (size_t)M * NQK * 2 == WS_VT && WS_VT + (size_t)NKV * M * 2 == WS_O && WS_O + (size_t)M * DM * 2 == WS_Y && WS_Y + (size_t)M * DM * 4 == WS_X, "ws map 3");
static_assert(WS_X + (size_t)M * DM * 4 == WS_H && WS_H + (size_t)M * FFH * 2 == WS_U && WS_U + (size_t)M * DM * 2 == WS_BG && WS_BG + (size_t)M * DM * 2 == WS_C && WS_C + (size_t)M * NGU * 4 == WS_END, "ws map 4");
constexpr int CW_TMO = 0;
constexpr int CW_GRP = 32768, N_GSEAM = 11, GRP_SIZE = 8;
static_assert((CW_GRP + N_GSEAM * 32 * 64) * 4 <= (int)CTL_ZERO_BYTES, "CTL words inside the memset region");
constexpr int CW_BAR = 4096;

constexpr int RING_OFF = 0, RING_BYTES = 131072;
constexpr int LDSCTL_OFF = RING_BYTES, MISC_OFF = LDSCTL_OFF + 320;
constexpr int LDS_BYTES = 147456;

#define GAS __attribute__((address_space(1)))
#define LAS __attribute__((address_space(3)))
typedef unsigned short bf16;
typedef unsigned v4u __attribute__((ext_vector_type(4)));
typedef unsigned v2u __attribute__((ext_vector_type(2)));
typedef float f32x4 __attribute__((ext_vector_type(4)));
typedef float f32x16 __attribute__((ext_vector_type(16)));
typedef short bf16x8 __attribute__((ext_vector_type(8)));
typedef GAS unsigned gu32;
#define RLX_AGENT __ATOMIC_RELAXED, __HIP_MEMORY_SCOPE_AGENT
#define LDS_WAIT() asm volatile("s_waitcnt lgkmcnt(0)" ::: "memory")
typedef float f32x2 __attribute__((ext_vector_type(2)));
typedef __bf16 bf16x2_t __attribute__((ext_vector_type(2)));
__device__ __forceinline__ unsigned pk2(float lo, float hi) { const f32x2 v = {lo, hi}; return __builtin_bit_cast(unsigned, __builtin_convertvector(v, bf16x2_t)); }
__device__ __forceinline__ unsigned f2bf(float f) { return pk2(f, 0.f) & 0xffffu; }
__device__ __forceinline__ unsigned pk4f8(float a, float b, float c, float d) { int w = __builtin_amdgcn_cvt_pk_fp8_f32(a, b, 0, false); w = __builtin_amdgcn_cvt_pk_fp8_f32(c, d, w, true); return (unsigned)w; }
__device__ __forceinline__ unsigned pk4i8(float a, float b, float c, float d) {
    const int ia = (int)__builtin_rintf(__builtin_amdgcn_fmed3f(a, -127.f, 127.f)), ib = (int)__builtin_rintf(__builtin_amdgcn_fmed3f(b, -127.f, 127.f));
    const int ic = (int)__builtin_rintf(__builtin_amdgcn_fmed3f(c, -127.f, 127.f)), id = (int)__builtin_rintf(__builtin_amdgcn_fmed3f(d, -127.f, 127.f));
    return (unsigned)(ia & 255) | ((unsigned)(ib & 255) << 8) | ((unsigned)(ic & 255) << 16) | ((unsigned)id << 24);
}
__device__ __forceinline__ size_t tl8_byte(int row, int k, int K) { return 2 * pg8::tl_off(row, k >> 1, K >> 1); }
constexpr int GU_BF = 0, GU_F8 = NGU / 256 - GU_BF;
constexpr float WQ_CLIP = 4.f;
constexpr float SC_X = 1.f, SC_WQKV = 256.f, SC_O = 16.f, SC_WO = 512.f, SC_WGU = 256.f;
__device__ __forceinline__ float bf2f(unsigned h) { return __builtin_bit_cast(float, h << 16); }
typedef _Float16 f16x2 __attribute__((ext_vector_type(2)));
__device__ __forceinline__ unsigned pk2h(float lo, float hi) { const f32x2 v = {lo, hi}; return __builtin_bit_cast(unsigned, __builtin_convertvector(v, f16x2)); }
__device__ __forceinline__ float h2f(unsigned h) { return (float)__builtin_bit_cast(_Float16, (unsigned short)h); }
#define MFMA32(a, b, c) __builtin_amdgcn_mfma_f32_32x32x16_bf16((a), (b), (c), 0, 0, 0)

namespace att {
typedef bf16x8 h16x8q;
constexpr int K_OFF = 0, VT_OFF = 65536;
constexpr float LOG2E = 1.4426950408889634f;
__device__ __forceinline__ void attn_unit(LAS unsigned char* lds, const bf16* __restrict__ QK, const bf16* __restrict__ VT, bf16* __restrict__ O, const float* __restrict__ sinks, int b, int g, int qb) {
    int tid_ = threadIdx.x; asm volatile("" : "+v"(tid_));
    const int tid = tid_, lane = tid & 63, r32 = lane & 31, hi = lane >> 5; const int wid = __builtin_amdgcn_readfirstlane(tid >> 6);
    const int q0 = qb * 128; const long rowbase = (long)b * SEQ;
    const int hh = wid >> 1, h = g * 4 + hh;
    h16x8q qf2[2][8];
#pragma unroll
    for (int t = 0; t < 2; ++t) { const bf16* qp = QK + (size_t)(rowbase + q0 + 32 * (2 * (wid & 1) + t) + r32) * NQK + h * HD + hi * 8;
#pragma unroll
        for (int ds = 0; ds < 8; ++ds) qf2[t][ds] = *(const h16x8q*)(qp + 16 * ds); }
    __syncthreads();
#pragma unroll
    for (int it = 0; it < 8; ++it) { const int idx = it * 512 + tid, key = idx >> 4, c = idx & 15; int pos = q0 - 128 + key; if (pos < 0) pos += 128;
        const v4u v = *(const v4u*)(QK + (size_t)(rowbase + pos) * NQK + NQ + g * HD + c * 8);
        *(LAS v4u*)(lds + K_OFF + key * 256 + ((c ^ (key & 15)) << 4)) = v; }
#pragma unroll
    for (int it = 0; it < 8; ++it) { const int idx = it * 512 + tid, d = idx >> 5, c = idx & 31; int pos = q0 - 128 + c * 8; if (pos < 0) pos += 128;
        const v4u v = *(const v4u*)(VT + (size_t)(g * HD + d) * M + rowbase + pos);
        *(LAS v4u*)(lds + VT_OFF + d * 512 + ((c ^ (d & 15)) << 4)) = v; }
    __syncthreads();
    const float sink2 = sinks[h] * LOG2E, sc = 0.08838834764831845f * LOG2E;
    const int pi = (r32 & ~12) | ((r32 & 4) << 1) | ((r32 & 8) >> 1);
#pragma unroll
    for (int t = 0; t < 2; ++t) {
        const int j = 2 * (wid & 1) + t;
        const h16x8q (&qf)[8] = qf2[t];
        f32x16 st[5];
#pragma unroll
        for (int kt = 0; kt < 5; ++kt) {
#pragma unroll
            for (int r = 0; r < 16; ++r) st[kt][r] = 0.f;
            const int kr = 32 * (j + kt) + pi; const LAS unsigned char* kp = lds + K_OFF + kr * 256;
#pragma unroll
            for (int ds = 0; ds < 8; ++ds) { const int c = 2 * ds + hi; const bf16x8 kf = *(const LAS bf16x8*)(kp + ((c ^ (kr & 15)) << 4)); st[kt] = MFMA32(kf, qf[ds], st[kt]); }
        }
        float mx = sink2;
#pragma unroll
        for (int kt = 0; kt < 5; ++kt)
#pragma unroll
            for (int r = 0; r < 16; ++r) { const int i = 16 * (r >> 3) + 8 * hi + (r & 7);
                bool ok = true; if (kt == 0) ok = i > r32; if (kt == 4) ok = i <= r32; if (q0 == 0 && j + kt < 4) ok = false;
                const float s = ok ? st[kt][r] * sc : -INFINITY; st[kt][r] = s; mx = fmaxf(mx, s); }
        mx = fmaxf(mx, __shfl_xor(mx, 32));
        float sum = 0.f;
#pragma unroll
        for (int kt = 0; kt < 5; ++kt)
#pragma unroll
            for (int r = 0; r < 16; ++r) { const float p = __builtin_amdgcn_exp2f(st[kt][r] - mx); st[kt][r] = p; sum += p; }
        sum += __shfl_xor(sum, 32);
        const float inv = 1.0f / (sum + __builtin_amdgcn_exp2f(sink2 - mx));
        bf16x8 pb[5][2];
#pragma unroll
        for (int kt = 0; kt < 5; ++kt)
#pragma unroll
            for (int m = 0; m < 2; ++m) { v4u w; w.x = pk2(st[kt][8 * m], st[kt][8 * m + 1]); w.y = pk2(st[kt][8 * m + 2], st[kt][8 * m + 3]); w.z = pk2(st[kt][8 * m + 4], st[kt][8 * m + 5]); w.w = pk2(st[kt][8 * m + 6], st[kt][8 * m + 7]);
                pb[kt][m] = __builtin_bit_cast(bf16x8, w); }
        const int orow = (int)rowbase + q0 + 32 * j + r32;
#pragma unroll
        for (int db = 0; db < 4; ++db) {
            f32x16 o;
#pragma unroll
            for (int r = 0; r < 16; ++r) o[r] = 0.f;
            const int d = 32 * db + r32; const LAS unsigned char* vp = lds + VT_OFF + d * 512;
#pragma unroll
            for (int kt = 0; kt < 5; ++kt)
#pragma unroll
                for (int m = 0; m < 2; ++m) { const int c = 4 * (j + kt) + 2 * m + hi; const bf16x8 vf = *(const LAS bf16x8*)(vp + ((c ^ (d & 15)) << 4)); o = MFMA32(vf, pb[kt][m], o); }
#pragma unroll
            for (int rg = 0; rg < 4; ++rg) { const float is = inv * SC_O;
                *(unsigned*)((unsigned char*)O + tl8_byte(orow, h * HD + 32 * db + 8 * rg + 4 * hi, NQ)) = pk4f8(o[4 * rg] * is, o[4 * rg + 1] * is, o[4 * rg + 2] * is, o[4 * rg + 3] * is); }
        }
        asm volatile("" ::: "memory"); __builtin_amdgcn_sched_barrier(0);
    }
}
}

#define XB_TMO      128
#define XB_XCNT(j)  (256  + 64 * (j))
#define XB_XSUB(j)  (1280 + 64 * (j))
#define XB_XGEN(j)  (2304 + 64 * (j))
#define XB_TOP      3328
#define XB_TOPGEN   3392
#define XCD_BAR_WORDS 3456
#define XB_SPIN_CAP (1u << 18)

__device__ __forceinline__ unsigned xb_ld(unsigned* p)              { return __hip_atomic_load(p, __ATOMIC_RELAXED, __HIP_MEMORY_SCOPE_AGENT); }
__device__ __forceinline__ unsigned xb_add(unsigned* p, unsigned v) { return __hip_atomic_fetch_add(p, v, __ATOMIC_RELAXED, __HIP_MEMORY_SCOPE_AGENT); }
__device__ __forceinline__ unsigned xb_xcc_id() { return (unsigned)__builtin_amdgcn_s_getreg((3 << 11) | 20) & 0xFu; }
#define XB_SPIN(cond, bar) do { unsigned _sp = 0; while (cond) { __builtin_amdgcn_s_sleep(1); \
    if ((++_sp & 255u) == 0u) { if (xb_ld(&(bar)[XB_TMO])) break; if (_sp > XB_SPIN_CAP) { atomicAdd(&(bar)[XB_TMO], 1u); break; } } } } while (0)

struct XcdBarrier {
    unsigned* bar; unsigned x;
    unsigned rank;
    volatile LAS unsigned* st;
};

__device__ __forceinline__ XcdBarrier xcd_barrier_post(unsigned* bar, volatile LAS unsigned* st) {
    XcdBarrier b; b.bar = bar; b.x = xb_xcc_id(); b.st = st; b.rank = 0u;
    if (threadIdx.x == 0) b.rank = xb_add(&bar[XB_XCNT(b.x)], 1u);
    return b;
}
__device__ __forceinline__ void xcd_barrier_complete(unsigned* bar, unsigned x, unsigned& nloc, unsigned& nx) {
    const unsigned G = gridDim.x * gridDim.y * gridDim.z;
    unsigned sum, cnt, mine, sp = 0u;
    for (;;) {
        sum = 0u; cnt = 0u; mine = 0u;
#pragma unroll
        for (unsigned j = 0; j < 16; ++j) { const unsigned c = xb_ld(&bar[XB_XCNT(j)]); sum += c; cnt += (c > 0u) ? 1u : 0u; mine = (j == x) ? c : mine; }
        if (sum == G) break;
        __builtin_amdgcn_s_sleep(1);
        if ((++sp & 255u) == 0u) { if (xb_ld(&bar[XB_TMO])) break; if (sp > XB_SPIN_CAP) { atomicAdd(&bar[XB_TMO], 1u); break; } }
    }
    nloc = mine > 0u ? mine : 1u; nx = cnt > 0u ? cnt : 1u;
}

__device__ __forceinline__ void xcd_barrier(const XcdBarrier& b) {
    asm volatile("s_waitcnt vmcnt(0)" ::: "memory");
    __syncthreads();
    if (threadIdx.x == 0) {
        unsigned* bar = b.bar;
        __builtin_amdgcn_s_waitcnt(0);
        unsigned nloc = b.st[0], nx = b.st[1];
        if (nloc == 0u) { xcd_barrier_complete(bar, b.x, nloc, nx); b.st[0] = nloc; b.st[1] = nx; }
        const unsigned old = xb_add(&bar[XB_XSUB(b.x)], 1u);
        const unsigned gen = old / nloc;
        if (old + 1u == (gen + 1u) * nloc) {
            __builtin_amdgcn_fence(__ATOMIC_RELEASE, "agent");
            asm volatile("s_waitcnt vmcnt(0)" ::: "memory");
            const unsigned og = xb_add(&bar[XB_TOP], 1u);
            const unsigned tg = og / nx;
            if (og + 1u == (tg + 1u) * nx) xb_add(&bar[XB_TOPGEN], 1u);
            else XB_SPIN(xb_ld(&bar[XB_TOPGEN]) == tg, bar);
            __builtin_amdgcn_fence(__ATOMIC_ACQUIRE, "agent");
            xb_add(&bar[XB_XGEN(b.x)], 1u);
            asm volatile("s_waitcnt vmcnt(0)" ::: "memory");
        } else {
            XB_SPIN(xb_ld(&bar[XB_XGEN(b.x)]) == gen, bar);
            __builtin_amdgcn_fence(__ATOMIC_ACQUIRE, "agent");
            asm volatile("s_waitcnt vmcnt(0)" ::: "memory");
        }
    }
    __syncthreads();
}


struct Frame {
    LAS unsigned char* lds;
    volatile LAS unsigned* MISC;
    gu32* ctl;
    int tid, wave, vcu, G;
};
__device__ __forceinline__ float wave_max(float v) {
#pragma unroll
    for (int o = 1; o < 64; o <<= 1) v = fmaxf(v, __shfl_xor(v, o));
    return v;
}
__device__ __forceinline__ float wave_sum(float v) {
#pragma unroll
    for (int o = 1; o < 64; o <<= 1) v += __shfl_xor(v, o);
    return v;
}
__device__ __forceinline__ void group_barrier(Frame& F, int seam, int pm) {
    asm volatile("s_waitcnt vmcnt(0)" ::: "memory");
    __syncthreads();
    if (F.tid == 0) {
        gu32* cnt = F.ctl + CW_GRP + (seam * 32 + pm) * 64;
        (void)__hip_atomic_fetch_add(cnt, 1u, RLX_AGENT);
        unsigned sp = 0;
        while (__hip_atomic_load(cnt, RLX_AGENT) < (unsigned)GRP_SIZE) { __builtin_amdgcn_s_sleep(1);
            if ((++sp & 255u) == 0u) { if (__hip_atomic_load(F.ctl + CW_TMO, RLX_AGENT)) break; if (sp > (1u << 18)) { __hip_atomic_store(F.ctl + CW_TMO, 1u, RLX_AGENT); break; } } }
        __builtin_amdgcn_fence(__ATOMIC_ACQUIRE, "agent");
        asm volatile("s_waitcnt vmcnt(0)" ::: "memory");
    }
    __syncthreads();
}
struct TItem { const float* W; bf16* WT; int K, N, k0, n0, drow0; };
__device__ __forceinline__ void t_load(const TItem& I, f32x4 (&ra)[8], f32x4 (&rb)[8], int lane) {
    const int q = lane & 15, pr = lane >> 4;
#pragma unroll
    for (int i = 0; i < 8; ++i) { const GAS float* src = (const GAS float*)I.W + (size_t)(I.k0 + 2 * (4 * i + pr)) * I.N + I.n0 + 4 * q; ra[i] = __builtin_nontemporal_load((const GAS f32x4*)src); rb[i] = __builtin_nontemporal_load((const GAS f32x4*)(src + I.N)); }
}
__device__ __forceinline__ void t_write_lds(LAS unsigned* T, const f32x4 (&ra)[8], const f32x4 (&rb)[8], int lane) {
    const int q = lane & 15, pr = lane >> 4;
#pragma unroll
    for (int i = 0; i < 8; ++i) { const int p = 4 * i + pr; v4u u; u.x = pk2(ra[i].x, rb[i].x); u.y = pk2(ra[i].y, rb[i].y); u.z = pk2(ra[i].z, rb[i].z); u.w = pk2(ra[i].w, rb[i].w);
        *(LAS v4u*)(T + p * 64 + ((q ^ ((p >> 2) & 7)) << 2)) = u; }
}
__device__ __forceinline__ void t_read_store(const LAS unsigned* T, const TItem& I, int lane) {
    const int c = lane & 7, nb = lane >> 3;
#pragma unroll
    for (int jj = 0; jj < 8; ++jj) { const int n = nb + 8 * jj, q = n >> 2, j = n & 3; const LAS unsigned* s = T + (4 * c) * 64 + ((q ^ c) << 2) + j;
        v4u o; o.x = s[0]; o.y = s[64]; o.z = s[128]; o.w = s[192];
        __builtin_nontemporal_store(o, (GAS v4u*)(I.WT + pg8::tl_off_w(I.drow0 + n, I.k0 + 8 * c, I.K))); }
}
__device__ __forceinline__ int map_pair128(int n, int half_n) {
    const int second = n >= half_n ? 1 : 0, nn = n - second * half_n; return (nn >> 7) * 256 + second * 128 + (nn & 127);
}
struct Ptrs {
    const float *x, *attn_w_in, *attn_sinks, *attn_w_out, *conv_w_in, *conv_w, *conv_w_out, *ln_mix_g, *ln_mix_b, *ffn_w_gate_up, *ffn_w_down, *ln_ffn_g, *ln_ffn_b;
    float* out; unsigned char* ws;
};
struct TItem8 { const float* W; unsigned char* WT; int N, k0, n0, drow0, q8, nat; float sc; };
__device__ __forceinline__ void t_load4(const TItem8& I, f32x4 (&ra)[8], f32x4 (&rb)[8], f32x4 (&rc)[8], f32x4 (&rd)[8], int lane) {
    const int q = lane & 15, pr = lane >> 4;
#pragma unroll
    for (int i = 0; i < 8; ++i) { const GAS float* src = (const GAS float*)I.W + (size_t)(I.k0 + 4 * (4 * i + pr)) * I.N + I.n0 + 4 * q;
        ra[i] = __builtin_nontemporal_load((const GAS f32x4*)src); rb[i] = __builtin_nontemporal_load((const GAS f32x4*)(src + I.N));
        rc[i] = __builtin_nontemporal_load((const GAS f32x4*)(src + 2 * (size_t)I.N)); rd[i] = __builtin_nontemporal_load((const GAS f32x4*)(src + 3 * (size_t)I.N)); }
}
__device__ __forceinline__ void t_write_lds4(LAS unsigned* T, const f32x4 (&ra)[8], const f32x4 (&rb)[8], const f32x4 (&rc)[8], const f32x4 (&rd)[8], float sc, int q8, int lane) {
    const int q = lane & 15, pr = lane >> 4;
#pragma unroll
    for (int i = 0; i < 8; ++i) { const int p = 4 * i + pr; v4u u;
        if (q8) { u.x = pk4i8(ra[i].x * sc, rb[i].x * sc, rc[i].x * sc, rd[i].x * sc); u.y = pk4i8(ra[i].y * sc, rb[i].y * sc, rc[i].y * sc, rd[i].y * sc); u.z = pk4i8(ra[i].z * sc, rb[i].z * sc, rc[i].z * sc, rd[i].z * sc); u.w = pk4i8(ra[i].w * sc, rb[i].w * sc, rc[i].w * sc, rd[i].w * sc); }
        else { u.x = pk4f8(ra[i].x * sc, rb[i].x * sc, rc[i].x * sc, rd[i].x * sc); u.y = pk4f8(ra[i].y * sc, rb[i].y * sc, rc[i].y * sc, rd[i].y * sc); u.z = pk4f8(ra[i].z * sc, rb[i].z * sc, rc[i].z * sc, rd[i].z * sc); u.w = pk4f8(ra[i].w * sc, rb[i].w * sc, rc[i].w * sc, rd[i].w * sc); }
        *(LAS v4u*)(T + p * 64 + ((q ^ ((p >> 2) & 7)) << 2)) = u; }
}
__device__ __forceinline__ void t_read_store8(const LAS unsigned* T, const TItem8& I, int lane) {
    const int c = lane & 7, nb = lane >> 3;
#pragma unroll
    for (int jj = 0; jj < 8; ++jj) { const int n = nb + 8 * jj, q = n >> 2, j = n & 3; const LAS unsigned* s = T + (4 * c) * 64 + ((q ^ c) << 2) + j;
        v4u o; o.x = s[0]; o.y = s[64]; o.z = s[128]; o.w = s[192];
        const int row = I.drow0 + n, prow = I.nat ? row : (row & ~31) + pg8::pinv32(row & 31);
        __builtin_nontemporal_store(o, (GAS v4u*)((GAS unsigned char*)I.WT + tl8_byte(prow, I.k0 + 16 * c, DM))); }
}
constexpr int J_QKV = (DM / 128) * (NQKV / 64), J_WO = (DM / 128) * (DM / 64), J_GU = (DM / 128) * (NGU / 64), J_STAGE1 = J_QKV + J_WO + J_GU, J_ALL = J_STAGE1 + J_GU;
__device__ __forceinline__ void p0_items8(Frame& F, const Ptrs& P, int first, int limit) {
    int lane_ = (int)(threadIdx.x & 63u); asm volatile("" : "+v"(lane_)); const int lane = lane_;
    LAS unsigned* T = (LAS unsigned*)(F.lds + RING_OFF + F.wave * 8192);
    int gw_ = F.vcu * NWAVES + F.wave; asm volatile("" : "+s"(gw_));
    const int gw = gw_, NGW = F.G * NWAVES;
    unsigned char* ws = P.ws;
    auto decode = [&](int it, TItem8& I) {
        int r = it; I.nat = 0;
        if (r < J_QKV) { const int nb = NQKV / 64; I.N = NQKV; I.k0 = 128 * (r / nb); I.n0 = 64 * (r % nb); I.drow0 = I.n0; I.nat = I.n0 >= NQK ? 1 : 0; I.W = P.attn_w_in; I.WT = ws + WS_WQKV; I.q8 = 1; I.sc = __builtin_bit_cast(float, (unsigned)F.MISC[22]); return; } r -= J_QKV;
        if (r < J_WO) { const int nb = DM / 64; I.N = DM; I.k0 = 128 * (r / nb); I.n0 = 64 * (r % nb); I.drow0 = I.n0; I.W = P.attn_w_out; I.WT = ws + WS_WO; I.q8 = 0; I.sc = SC_WO; return; } r -= J_WO;
        { const int l = r / J_GU; r %= J_GU; const int nb = NGU / 64; I.N = NGU; I.k0 = 128 * (r / nb); I.n0 = 64 * (r % nb); I.drow0 = map_pair128(I.n0, FFH);
          I.W = P.ffn_w_gate_up + (size_t)l * DM * NGU; I.WT = ws + WS_WGU8 + (size_t)l * NGU * DM; I.q8 = 1; I.sc = __builtin_bit_cast(float, (unsigned)F.MISC[20 + l]); }
    };
    {   int it = first + gw; TItem8 cur, nxt; f32x4 ra[8], rb[8], rc[8], rd[8];
        if (it < limit) { decode(it, cur); t_load4(cur, ra, rb, rc, rd, lane); }
        while (it < limit) {
            t_write_lds4(T, ra, rb, rc, rd, cur.sc, cur.q8, lane);
            const int nit = it + NGW;
            if (nit < limit) { decode(nit, nxt); t_load4(nxt, ra, rb, rc, rd, lane); }
            LDS_WAIT(); asm volatile("" ::: "memory");
            t_read_store8(T, cur, lane);
            LDS_WAIT(); asm volatile("" ::: "memory");
            cur = nxt; it = nit;
        }
    }
}
constexpr int I_AIN = (DM / 64) * (NQKV / 64), I_SQ = (DM / 64) * (DM / 64), I_CI = (DM / 64) * (NCI / 64), I_GU = (DM / 64) * (2 * GU_BF * 2)  , I_DN = (FFH / 64) * (DM / 64);
constexpr int NITEMS = I_AIN + 2 * I_SQ + I_CI + 2 * I_GU + 2 * I_DN;
constexpr int N_STAGE1 = I_AIN + I_SQ + I_DN + I_GU;
__device__ __forceinline__ void p0_items(Frame& F, const Ptrs& P, int first, int limit) {
    int lane_ = (int)(threadIdx.x & 63u); asm volatile("" : "+v"(lane_)); const int lane = lane_;
    LAS unsigned* T = (LAS unsigned*)(F.lds + RING_OFF + F.wave * 8192);
    const int gw = F.vcu * NWAVES + F.wave, NGW = F.G * NWAVES;
    unsigned char* ws = P.ws;
    auto decode = [&](int it, TItem& I) {
        int r = it;
        if (r < I_AIN) { const int nb = NQKV / 64; I.K = DM; I.N = NQKV; I.k0 = 64 * (r / nb); I.n0 = 64 * (r % nb); I.drow0 = I.n0; I.W = P.attn_w_in; I.WT = (bf16*)(ws + WS_WQKV); return; } r -= I_AIN;
        if (r < I_SQ) { const int nb = DM / 64; I.K = DM; I.N = DM; I.k0 = 64 * (r / nb); I.n0 = 64 * (r % nb); I.drow0 = I.n0; I.W = P.attn_w_out; I.WT = (bf16*)(ws + WS_WO); return; } r -= I_SQ;
        int l = 0;
        if (r >= I_DN + I_GU) { r -= I_DN + I_GU; l = 1;
            if (r < I_CI) { const int nb = NCI / 64; I.K = DM; I.N = NCI; I.k0 = 64 * (r / nb); I.n0 = 64 * (r % nb);
                I.drow0 = I.n0 < DM ? 2 * DM + I.n0 : map_pair128(I.n0 - DM, DM);
                I.W = P.conv_w_in; I.WT = (bf16*)(ws + WS_WCI); return; } r -= I_CI;
            if (r < I_SQ) { const int nb = DM / 64; I.K = DM; I.N = DM; I.k0 = 64 * (r / nb); I.n0 = 64 * (r % nb); I.drow0 = I.n0; I.W = P.conv_w_out; I.WT = (bf16*)(ws + WS_WCO); return; } r -= I_SQ; }
        if (r < I_DN) { const int nb = DM / 64; I.K = FFH; I.N = DM; I.k0 = 64 * (r / nb); I.n0 = 64 * (r % nb); I.drow0 = I.n0;
            I.W = P.ffn_w_down + (size_t)l * FFH * DM; I.WT = (bf16*)(ws + (l ? WS_WD1 : WS_WD0)); return; } r -= I_DN;
        { const int nb = GU_BF > 0 ? 2 * GU_BF * 2 : 1, cb = r % nb; I.K = DM; I.N = NGU; I.k0 = 64 * (r / nb); I.n0 = 64 * (cb < GU_BF * 2 ? cb : cb + (FFH / 64 - GU_BF * 2)); I.drow0 = map_pair128(I.n0, FFH);
            I.W = P.ffn_w_gate_up + (size_t)l * DM * NGU; I.WT = (bf16*)(ws + (l ? WS_WGU1 : WS_WGU0)); }
    };
    {
        int it = first + gw; TItem cur, nxt; f32x4 ra[8], rb[8];
        if (it < limit) { decode(it, cur); t_load(cur, ra, rb, lane); }
        while (it < limit) {
            t_write_lds(T, ra, rb, lane);
            const int nit = it + NGW;
            if (nit < limit) { decode(nit, nxt); t_load(nxt, ra, rb, lane); }
            LDS_WAIT(); asm volatile("" ::: "memory");
            t_read_store(T, cur, lane);
            LDS_WAIT(); asm volatile("" ::: "memory");
            cur = nxt; it = nit;
        }
    }
}
__device__ __forceinline__ void p0_x(Frame& F, const Ptrs& P) {
    int lane_ = (int)(threadIdx.x & 63u); asm volatile("" : "+v"(lane_)); const int lane = lane_;
    unsigned char* ws = P.ws;
    const int gw = F.vcu * NWAVES + F.wave, NGW = F.G * NWAVES;
    for (int m = gw; m < M; m += NGW) {
        const GAS f32x4* xr = (const GAS f32x4*)(P.x + (size_t)m * DM) + 2 * lane; f32x4 a[8], b2[8]; float amax = 0.f;
#pragma unroll
        for (int j = 0; j < 8; ++j) { a[j] = __builtin_nontemporal_load(xr + 128 * j); b2[j] = __builtin_nontemporal_load(xr + 128 * j + 1); }
#pragma unroll
        for (int j = 0; j < 8; ++j) amax = fmaxf(amax, fmaxf(fmaxf(fmaxf(fabsf(a[j].x), fabsf(a[j].y)), fmaxf(fabsf(a[j].z), fabsf(a[j].w))), fmaxf(fmaxf(fabsf(b2[j].x), fabsf(b2[j].y)), fmaxf(fabsf(b2[j].z), fabsf(b2[j].w)))));
        amax = fmaxf(wave_max(amax), 1e-20f); const float qs = 127.f / amax;
        if (lane == 0) *(GAS float*)((GAS float*)(ws + WS_RSX) + m) = amax * (1.f / 127.f);
        GAS v4u* xh = (GAS v4u*)(ws + WS_X) + (size_t)m * (DM / 8) + lane;
#pragma unroll
        for (int j = 0; j < 8; ++j) { v2u o; o.x = pk4i8(a[j].x * qs, a[j].y * qs, a[j].z * qs, a[j].w * qs); o.y = pk4i8(b2[j].x * qs, b2[j].y * qs, b2[j].z * qs, b2[j].w * qs);
            *(GAS v2u*)((GAS unsigned char*)(ws + WS_XB8) + tl8_byte(m, 512 * j + 8 * lane, DM)) = o;
            v4u h; h.x = pk2h(a[j].x, a[j].y); h.y = pk2h(a[j].z, a[j].w); h.z = pk2h(b2[j].x, b2[j].y); h.w = pk2h(b2[j].z, b2[j].w); xh[64 * j] = h; }
    }
}
__device__ __forceinline__ void ln_phase(Frame& F, const bf16* __restrict__ Y, const float* __restrict__ gam, const float* __restrict__ bet, float* __restrict__ XO, bf16* __restrict__ XBO, unsigned char* __restrict__ XB8O, float* __restrict__ RS, float* __restrict__ ST, int mbeg, int mend, int mstep) {
    int lane_ = (int)(threadIdx.x & 63u); asm volatile("" : "+v"(lane_)); const int lane = lane_;
    for (int m = mbeg; m < mend; m += mstep) {
        asm volatile("" ::: "memory");
        const GAS v4u* yr = (const GAS v4u*)(Y + (size_t)m * DM) + lane;
        v4u raw[8];
#pragma unroll
        for (int j = 0; j < 8; ++j) raw[j] = __builtin_nontemporal_load(yr + 64 * j);
        float v[8][8]; float s = 0.f;
#pragma unroll
        for (int j = 0; j < 8; ++j) { v[j][0] = h2f(raw[j].x & 0xffffu); v[j][1] = h2f(raw[j].x >> 16); v[j][2] = h2f(raw[j].y & 0xffffu); v[j][3] = h2f(raw[j].y >> 16);
            v[j][4] = h2f(raw[j].z & 0xffffu); v[j][5] = h2f(raw[j].z >> 16); v[j][6] = h2f(raw[j].w & 0xffffu); v[j][7] = h2f(raw[j].w >> 16);
            s += ((v[j][0] + v[j][1]) + (v[j][2] + v[j][3])) + ((v[j][4] + v[j][5]) + (v[j][6] + v[j][7])); }
        const float mean = wave_sum(s) * (1.f / DM); float s2 = 0.f;
#pragma unroll
        for (int j = 0; j < 8; ++j)
#pragma unroll
            for (int e = 0; e < 8; ++e) { v[j][e] -= mean; s2 += v[j][e] * v[j][e]; }
        const float rstd = 1.f / sqrtf(wave_sum(s2) * (1.f / DM) + LN_EPS);
        if (ST && lane == 0) *(GAS f32x2*)(ST + 2 * (size_t)m) = (f32x2){mean, rstd};
        const GAS f32x4* gp = (const GAS f32x4*)gam + 2 * lane; const GAS f32x4* bp = (const GAS f32x4*)bet + 2 * lane;
        if (XB8O) {
            float amax = 0.f;
#pragma unroll
            for (int j = 0; j < 8; ++j) { const f32x4 g0 = gp[128 * j], g1 = gp[128 * j + 1], b0 = bp[128 * j], b1 = bp[128 * j + 1];
                const f32x4 o0 = (f32x4){v[j][0], v[j][1], v[j][2], v[j][3]} * rstd * g0 + b0, o1 = (f32x4){v[j][4], v[j][5], v[j][6], v[j][7]} * rstd * g1 + b1;
                v[j][0] = o0.x; v[j][1] = o0.y; v[j][2] = o0.z; v[j][3] = o0.w; v[j][4] = o1.x; v[j][5] = o1.y; v[j][6] = o1.z; v[j][7] = o1.w;
#pragma unroll
                for (int e = 0; e < 8; ++e) amax = fmaxf(amax, fabsf(v[j][e])); }
            amax = fmaxf(wave_max(amax), 1e-20f); const float qs = 127.f / amax;
            if (lane == 0) *(GAS float*)(RS + m) = amax * (1.f / 127.f);
#pragma unroll
            for (int j = 0; j < 8; ++j) { if (XBO) { v4u w; w.x = pk2(v[j][0], v[j][1]); w.y = pk2(v[j][2], v[j][3]); w.z = pk2(v[j][4], v[j][5]); w.w = pk2(v[j][6], v[j][7]); *(GAS v4u*)(XBO + pg8::tl_off(m, 512 * j + 8 * lane, DM)) = w; }
                v2u w8; w8.x = pk4i8(v[j][0] * qs, v[j][1] * qs, v[j][2] * qs, v[j][3] * qs); w8.y = pk4i8(v[j][4] * qs, v[j][5] * qs, v[j][6] * qs, v[j][7] * qs); *(GAS v2u*)((GAS unsigned char*)XB8O + tl8_byte(m, 512 * j + 8 * lane, DM)) = w8; }
        } else
#pragma unroll
        for (int j = 0; j < 8; ++j) { const f32x4 g0 = gp[128 * j], g1 = gp[128 * j + 1], b0 = bp[128 * j], b1 = bp[128 * j + 1];
            const f32x4 o0 = (f32x4){v[j][0], v[j][1], v[j][2], v[j][3]} * rstd * g0 + b0, o1 = (f32x4){v[j][4], v[j][5], v[j][6], v[j][7]} * rstd * g1 + b1;
            if (XBO) { v4u w; w.x = pk2(o0.x, o0.y); w.y = pk2(o0.z, o0.w); w.z = pk2(o1.x, o1.y); w.w = pk2(o1.z, o1.w); *(GAS v4u*)(XBO + pg8::tl_off(m, 512 * j + 8 * lane, DM)) = w;
                       }
            else { GAS f32x4* xo = (GAS f32x4*)(XO + (size_t)m * DM) + 2 * lane + 128 * j; xo[0] = o0; xo[1] = o1; } }
    }
}
__device__ __forceinline__ void conv_phase(Frame& F, const bf16* __restrict__ U, const bf16* __restrict__ BG, const float* __restrict__ cw, bf16* __restrict__ V2, int jbeg, int jend, int jstep) {
    constexpr int NSEG = M / 32, NJOB = NSEG * 8;
    int lane_ = (int)(threadIdx.x & 63u); asm volatile("" : "+v"(lane_)); const int lane = lane_;
    for (int job = jbeg; job < jend; job += jstep) {
        const int cg = job & 7, seg = job >> 3, c0 = cg * 512 + lane * 8, r0 = seg * 32;
        float w0[8], w1[8], w2[8];
#pragma unroll
        for (int e = 0; e < 8; ++e) { w0[e] = cw[c0 + e]; w1[e] = cw[DM + c0 + e]; w2[e] = cw[2 * DM + c0 + e]; }
        float u1[8], u2[8];
        if ((r0 % SEQ) == 0) {
#pragma unroll
            for (int e = 0; e < 8; ++e) { u1[e] = 0.f; u2[e] = 0.f; }
        } else {
            const v4u a = *(const v4u*)(U + (size_t)(r0 - 1) * DM + c0), b2 = *(const v4u*)(U + (size_t)(r0 - 2) * DM + c0);
            u1[0] = bf2f(a.x & 0xffffu); u1[1] = bf2f(a.x >> 16); u1[2] = bf2f(a.y & 0xffffu); u1[3] = bf2f(a.y >> 16); u1[4] = bf2f(a.z & 0xffffu); u1[5] = bf2f(a.z >> 16); u1[6] = bf2f(a.w & 0xffffu); u1[7] = bf2f(a.w >> 16);
            u2[0] = bf2f(b2.x & 0xffffu); u2[1] = bf2f(b2.x >> 16); u2[2] = bf2f(b2.y & 0xffffu); u2[3] = bf2f(b2.y >> 16); u2[4] = bf2f(b2.z & 0xffffu); u2[5] = bf2f(b2.z >> 16); u2[6] = bf2f(b2.w & 0xffffu); u2[7] = bf2f(b2.w >> 16);
        }
#pragma unroll 4
        for (int t = 0; t < 32; ++t) {
            const v4u a = __builtin_nontemporal_load((const v4u*)(U + (size_t)(r0 + t) * DM + c0)), g4 = __builtin_nontemporal_load((const v4u*)(BG + (size_t)(r0 + t) * DM + c0));
            float u0[8], bg[8];
            u0[0] = bf2f(a.x & 0xffffu); u0[1] = bf2f(a.x >> 16); u0[2] = bf2f(a.y & 0xffffu); u0[3] = bf2f(a.y >> 16); u0[4] = bf2f(a.z & 0xffffu); u0[5] = bf2f(a.z >> 16); u0[6] = bf2f(a.w & 0xffffu); u0[7] = bf2f(a.w >> 16);
            bg[0] = bf2f(g4.x & 0xffffu); bg[1] = bf2f(g4.x >> 16); bg[2] = bf2f(g4.y & 0xffffu); bg[3] = bf2f(g4.y >> 16); bg[4] = bf2f(g4.z & 0xffffu); bg[5] = bf2f(g4.z >> 16); bg[6] = bf2f(g4.w & 0xffffu); bg[7] = bf2f(g4.w >> 16);
            float o[8];
#pragma unroll
            for (int e = 0; e < 8; ++e) { o[e] = bg[e] * (w0[e] * u2[e] + w1[e] * u1[e] + w2[e] * u0[e]); u2[e] = u1[e]; u1[e] = u0[e]; }
            v4u w; w.x = pk2(o[0], o[1]); w.y = pk2(o[2], o[3]); w.z = pk2(o[4], o[5]); w.w = pk2(o[6], o[7]);
            *(v4u*)(V2 + pg8::tl_off(r0 + t, c0, DM)) = w;
        }
    }
}

struct Args { const float* in[13]; float* out; unsigned char* ws; int ph_lo, ph_hi, use_bar, pad; };
__global__ void __launch_bounds__(NWAVES * 64, 2) mk_fwd(Args args) {
    extern __shared__ __attribute__((aligned(16))) unsigned char lds[];
    Frame F;
    F.lds = (LAS unsigned char*)lds;
    F.MISC = (volatile LAS unsigned*)(F.lds + MISC_OFF);
    F.tid = threadIdx.x; F.wave = __builtin_amdgcn_readfirstlane(F.tid >> 6);
    F.G = gridDim.x; { const int bx = blockIdx.x; F.vcu = (F.G % 8 == 0) ? (bx % 8) * (F.G / 8) + bx / 8 : bx; }
    unsigned char* ws = args.ws;
    F.ctl = (gu32*)(ws + WS_CTL);
    Ptrs P;
    P.x = args.in[0]; P.attn_w_in = args.in[1]; P.attn_sinks = args.in[2]; P.attn_w_out = args.in[3]; P.conv_w_in = args.in[4]; P.conv_w = args.in[5]; P.conv_w_out = args.in[6];
    P.ln_mix_g = args.in[7]; P.ln_mix_b = args.in[8]; P.ffn_w_gate_up = args.in[9]; P.ffn_w_down = args.in[10]; P.ln_ffn_g = args.in[11]; P.ln_ffn_b = args.in[12]; P.out = args.out; P.ws = ws;
    for (int u = F.tid; u < (LDS_BYTES - LDSCTL_OFF) / 4; u += NWAVES * 64) ((LAS unsigned*)(F.lds + LDSCTL_OFF))[u] = 0u;
    __syncthreads();
    {   float sq[3];
#pragma unroll
        for (int l = 0; l < 3; ++l) { const int N = l < 2 ? NGU : NQKV, cstep = l < 2 ? 40 : 12;
            const GAS float* W = (const GAS float*)(l < 2 ? P.ffn_w_gate_up + (size_t)l * DM * NGU : P.attn_w_in); float a = 0.f;
#pragma unroll
            for (int i = 0; i < 16; ++i) { const f32x4 v = *(const GAS f32x4*)(W + (size_t)(i * 257 + 13) * N + cstep * F.tid); a += (v.x * v.x + v.y * v.y) + (v.z * v.z + v.w * v.w); }
            sq[l] = wave_sum(a); }
        if ((F.tid & 63) == 0) { F.MISC[32 + F.wave] = __builtin_bit_cast(unsigned, sq[0]); F.MISC[40 + F.wave] = __builtin_bit_cast(unsigned, sq[1]); F.MISC[48 + F.wave] = __builtin_bit_cast(unsigned, sq[2]); }
        __syncthreads();
        if (F.tid == 0) {
#pragma unroll
            for (int l = 0; l < 3; ++l) { float t = 0.f;
#pragma unroll
                for (int w = 0; w < NWAVES; ++w) t += __builtin_bit_cast(float, (unsigned)F.MISC[32 + 8 * l + w]);
                const float sigma = sqrtf(t * (1.f / (16.f * NWAVES * 64.f * 4.f))); F.MISC[20 + l] = __builtin_bit_cast(unsigned, 127.f / (WQ_CLIP * fmaxf(sigma, 1e-30f))); } }
        __syncthreads();
    }
    XcdBarrier bar; bar.bar = (unsigned*)(F.ctl + CW_BAR); bar.x = 0; bar.st = nullptr; bar.rank = 0u;
    if (args.use_bar) { bar = xcd_barrier_post((unsigned*)(F.ctl + CW_BAR), F.MISC + 8); if (F.tid == 0) { F.MISC[10] = bar.rank; F.MISC[11] = bar.x; } }
    bool pl = false;
    int cidx = (int)blockIdx.x;
#if DEV_MODE
    const int lo = args.ph_lo, hi = args.ph_hi;
#else
    constexpr int lo = 0, hi = NPHASE;
#endif
#define IN(k) (lo <= (k) && (k) < hi)
#define SEAM(k) do { if (IN(k) && IN((k) + 1)) xcd_barrier(bar); } while (0)
#define GSEAM(k) do { if (IN(k) && IN((k) + 1)) { if (pl) group_barrier(F, (k) - 3, pmg); else xcd_barrier(bar); } } while (0)
#define PHASE_BEGIN(k) if (IN(k)) {
#define PHASE_END }

    PHASE_BEGIN(0) { p0_x(F, P); p0_items8(F, P, 0, args.use_bar ? J_STAGE1 : J_ALL); p0_items(F, P, I_AIN + I_SQ, args.use_bar ? N_STAGE1 : NITEMS); } PHASE_END
    SEAM(0);
    if (args.use_bar && IN(0) && IN(1)) {
        if (F.tid == 0) { bool ok = (F.G % 8) == 0;
            for (unsigned j = 0; j < 16; ++j) { const unsigned c = xb_ld(&bar.bar[XB_XCNT(j)]); ok = ok && (c == (j < 8u ? (unsigned)F.G / 8u : 0u)); }
            F.MISC[12] = ok ? 1u : 0u; }
        __syncthreads();
        if (F.MISC[12] != 0u) cidx = (int)(F.MISC[10] * 8u + F.MISC[11]);
        cidx = __builtin_amdgcn_readfirstlane(cidx);
        if (F.G % 8 == 0) F.vcu = (cidx % 8) * (F.G / 8) + cidx / 8;
        pl = (F.MISC[12] != 0u) && F.G == 256;
    }
    const int pmg = 4 * (cidx & 7) + ((cidx >> 3) & 3), rankg = cidx >> 5;
    const int gwv = F.vcu * NWAVES + F.wave, NGWV = F.G * NWAVES;
#pragma unroll 1
    for (int layer = 0; layer < 2; ++layer) {
        const int pb = 1 + 7 * layer;
        { GAS unsigned char* wl = (GAS unsigned char*)args.ws; asm volatile("" : "+s"(wl)); ws = (unsigned char*)wl; }
        bf16* const XB = (bf16*)(ws + WS_XB); unsigned char* const XB8 = ws + WS_XB8; float* const RSf = (float*)(ws + WS_RS); bf16* const QKb = (bf16*)(ws + WS_QK); bf16* const VTb = (bf16*)(ws + WS_VT); bf16* const Ob = (bf16*)(ws + WS_O);
        bf16* const Yh = (bf16*)(ws + WS_Y); bf16* const XH = (bf16*)(ws + WS_X); float* const STf = (float*)(ws + WS_ST); bf16* const Hb = (bf16*)(ws + WS_H); bf16* const Ub = (bf16*)(ws + WS_U); bf16* const BGb = (bf16*)(ws + WS_BG);
        if (layer == 0) {
            PHASE_BEGIN(1) {
                { pg8::Gemm g{(const bf16*)XB8, (const bf16*)(ws + WS_WQKV), M, NQK, DM / 2}; pg8::StaticOrder S; S.init(M, NQK, F.G, cidx);
                  pg8::EpiBf16 E{QKb, NQK, 1.f / __builtin_bit_cast(float, (unsigned)F.MISC[22]), (const float*)(ws + WS_RSX), 0};
                  pg8::gemm_phase<pg8::EpiBf16, pg8::StaticOrder, true, true, false, true>(F.lds + RING_OFF, g, S, E); }
                { pg8::Gemm g{(const bf16*)(ws + WS_WQKV + (size_t)NQK * DM), (const bf16*)XB8, NKV, M, DM / 2, 1}; pg8::StaticOrder S; S.init(NKV, M, F.G, (cidx + F.G / 2) % F.G);
                  pg8::EpiBf16 E{VTb, M, 1.f / __builtin_bit_cast(float, (unsigned)F.MISC[22]), (const float*)(ws + WS_RSX), 1};
                  pg8::gemm_phase<pg8::EpiBf16, pg8::StaticOrder, true, true, false, true>(F.lds + RING_OFF, g, S, E); }
            } PHASE_END
            SEAM(1);
            PHASE_BEGIN(2) {
                for (int u = F.vcu; u < BATCH * NKVH * (SEQ / 128); u += F.G)
                    att::attn_unit(F.lds + RING_OFF, QKb, VTb, Ob, P.attn_sinks, u >> 8, (u >> 5) & 7, u & 31);
            } PHASE_END
            SEAM(2);
        } else {
            PHASE_BEGIN(8) {
                pg8::Gemm g{XB, (const bf16*)(ws + WS_WCI), M, NCI, DM}; pg8::StaticOrder S; S.init(M, NCI, F.G, cidx);
                pg8::EpiConvIn E{Ub, BGb, DM, DM / 128};
                pg8::gemm_phase<pg8::EpiConvIn, pg8::StaticOrder, true, true>(F.lds + RING_OFF, g, S, E);
            } PHASE_END
            SEAM(8);
            PHASE_BEGIN(9) { if (pl) { const int jb = (8 * pmg + rankg) * 8 + F.wave; conv_phase(F, Ub, BGb, P.conv_w, Ob, jb, jb + 1, 1); } else conv_phase(F, Ub, BGb, P.conv_w, Ob, gwv, (M / 32) * 8, NGWV); } PHASE_END
            GSEAM(9);
        }
        PHASE_BEGIN(pb + 2) {
            pg8::StaticOrder S; S.init(M, DM, F.G, cidx);
            if (layer == 0) { pg8::Gemm g{Ob, (const bf16*)(ws + WS_WO), M, DM, DM / 2}; pg8::EpiResF16 E{XH, Yh, DM, ALPHA, 1.f / (SC_O * SC_WO)};
                pg8::gemm_phase<pg8::EpiResF16, pg8::StaticOrder, true, true, true>(F.lds + RING_OFF, g, S, E); }
            else { pg8::Gemm g{Ob, (const bf16*)(ws + WS_WCO), M, DM, DM}; pg8::EpiResLN E{Yh, DM, ALPHA, STf, P.ln_ffn_g, P.ln_ffn_b};
                pg8::gemm_phase<pg8::EpiResLN, pg8::StaticOrder, true, true>(F.lds + RING_OFF, g, S, E); }
        } PHASE_END
        GSEAM(pb + 2);
        PHASE_BEGIN(pb + 3) { const int mb = pl ? 256 * pmg + 32 * rankg + F.wave : gwv; ln_phase(F, Yh, P.ln_mix_g + layer * DM, P.ln_mix_b + layer * DM, (float*)nullptr, GU_BF > 0 ? XB : (bf16*)nullptr, XB8, RSf, STf, mb, pl ? 256 * pmg + 32 * rankg + 32 : M, pl ? NWAVES : NGWV); } PHASE_END
        GSEAM(pb + 3);
        PHASE_BEGIN(pb + 4) {
            if (GU_BF > 0) { pg8::Gemm g{XB, (const bf16*)(ws + (layer ? WS_WGU1 : WS_WGU0)), M, GU_BF * 256, DM}; pg8::StaticOrder S; S.init(M, GU_BF * 256, F.G, cidx);
              pg8::EpiSwiGLU E{Hb, FFH, 1.f, 0, (const float*)nullptr};
              pg8::gemm_phase<pg8::EpiSwiGLU, pg8::StaticOrder, true, true>(F.lds + RING_OFF, g, S, E); }
            { pg8::Gemm g{(const bf16*)XB8, (const bf16*)(ws + WS_WGU8 + (size_t)layer * (GU_F8 * 256) * DM), M, GU_F8 * 256, DM / 2}; pg8::StaticOrder S; S.init(M, GU_F8 * 256, F.G, cidx);
              pg8::EpiSwiGLU E{Hb, FFH, 1.f / __builtin_bit_cast(float, (unsigned)F.MISC[20 + layer]), GU_BF, RSf};
              pg8::gemm_phase<pg8::EpiSwiGLU, pg8::StaticOrder, true, true, false, true>(F.lds + RING_OFF, g, S, E); }
        } PHASE_END
        GSEAM(pb + 4);
        PHASE_BEGIN(pb + 5) {
            pg8::Gemm g{Hb, (const bf16*)(ws + (layer ? WS_WD1 : WS_WD0)), M, DM, FFH}; pg8::StaticOrder S; S.init(M, DM, F.G, cidx);
            pg8::EpiResLN E{Yh, DM, ALPHA, STf, P.ln_mix_g + layer * DM, P.ln_mix_b + layer * DM};
            pg8::gemm_phase<pg8::EpiResLN, pg8::StaticOrder, true, true>(F.lds + RING_OFF, g, S, E);
        } PHASE_END
        GSEAM(pb + 5);
        PHASE_BEGIN(pb + 6) { const int mb = pl ? 256 * pmg + 32 * rankg + F.wave : gwv; ln_phase(F, Yh, P.ln_ffn_g + layer * DM, P.ln_ffn_b + layer * DM, layer ? P.out : (float*)nullptr, layer ? (bf16*)nullptr : XB, (unsigned char*)nullptr, (float*)nullptr, layer ? (float*)nullptr : STf, mb, pl ? 256 * pmg + 32 * rankg + 32 : M, pl ? NWAVES : NGWV); } PHASE_END
        if (layer == 0) { if (args.use_bar && IN(7) && IN(8)) { p0_items8(F, P, J_STAGE1, J_ALL); p0_items(F, P, N_STAGE1, NITEMS); xcd_barrier(bar); } else GSEAM(pb + 6); }
    }
#undef GSEAM
#undef IN
#undef PHASE_BEGIN
#undef PHASE_END
#undef SEAM
}

#if DEV_MODE
__device__ __forceinline__ int crow16(int r, int hi) { return (r & 3) + 8 * (r >> 2) + 4 * hi; }
template <bool OUT_BF16> __global__ void __launch_bounds__(256) ref_gemm(const bf16* __restrict__ A, const bf16* __restrict__ Bt, void* __restrict__ C, int M_, int N_, int K_, int ldc) {
    __shared__ __attribute__((aligned(16))) bf16 As[128 * 40];
    __shared__ __attribute__((aligned(16))) bf16 Bs[128 * 40];
    const int tid = threadIdx.x, lane = tid & 63, w = tid >> 6, wm = w >> 1, wn = w & 1, r32 = lane & 31, hi = lane >> 5;
    const int bm = blockIdx.y * 128, bn = blockIdx.x * 128;
    f32x16 acc[2][2];
#pragma unroll
    for (int a = 0; a < 2; ++a)
#pragma unroll
        for (int b = 0; b < 2; ++b)
#pragma unroll
            for (int r = 0; r < 16; ++r) acc[a][b][r] = 0.f;
    for (int k0 = 0; k0 < K_; k0 += 32) {
#pragma unroll
        for (int i = 0; i < 2; ++i) { const int idx = tid + 256 * i, row = idx >> 2, ch = idx & 3;
            *(v4u*)&As[row * 40 + ch * 8] = *(const v4u*)&A[pg8::tl_off(bm + row, k0 + ch * 8, K_)];
            *(v4u*)&Bs[row * 40 + ch * 8] = *(const v4u*)&Bt[pg8::tl_off(bn + row, k0 + ch * 8, K_)]; }
        __syncthreads();
#pragma unroll
        for (int ks = 0; ks < 2; ++ks) {
            bf16x8 a[2], b[2];
#pragma unroll
            for (int i = 0; i < 2; ++i) { a[i] = *(const bf16x8*)&As[(wm * 64 + i * 32 + r32) * 40 + ks * 16 + hi * 8]; b[i] = *(const bf16x8*)&Bs[(wn * 64 + i * 32 + r32) * 40 + ks * 16 + hi * 8]; }
#pragma unroll
            for (int mi = 0; mi < 2; ++mi)
#pragma unroll
                for (int ni = 0; ni < 2; ++ni) acc[mi][ni] = MFMA32(a[mi], b[ni], acc[mi][ni]);
        }
        __syncthreads();
    }
#pragma unroll
    for (int mi = 0; mi < 2; ++mi)
#pragma unroll
        for (int ni = 0; ni < 2; ++ni)
#pragma unroll
            for (int r = 0; r < 16; ++r) { const size_t row = bm + wm * 64 + mi * 32 + crow16(r, hi), col = bn + wn * 64 + ni * 32 + r32;
                if (OUT_BF16) ((bf16*)C)[row * ldc + col] = (bf16)f2bf(acc[mi][ni][r]); else ((float*)C)[row * ldc + col] = acc[mi][ni][r]; }
}
__global__ void __launch_bounds__(256) ref_res(const float* __restrict__ C, const bf16* __restrict__ R, bf16* __restrict__ Y, float alpha, size_t n) {
    for (size_t i = (size_t)blockIdx.x * 256 + threadIdx.x; i < n; i += (size_t)gridDim.x * 256) Y[i] = (bf16)(pk2h(alpha * h2f(R[i]) + C[i], 0.f) & 0xffffu);
}
__global__ void __launch_bounds__(256) ref_res_ln(const float* __restrict__ C, bf16* __restrict__ Y, const float* __restrict__ ST, const float* __restrict__ G, const float* __restrict__ B, float alpha, size_t n) {
    for (size_t i = (size_t)blockIdx.x * 256 + threadIdx.x; i < n; i += (size_t)gridDim.x * 256) { const size_t m = i / DM; const int c = (int)(i % DM);
        const float x = (h2f(Y[i]) - ST[2 * m]) * ST[2 * m + 1] * G[c] + B[c]; Y[i] = (bf16)(pk2h(alpha * x + C[i], 0.f) & 0xffffu); }
}
__global__ void __launch_bounds__(256) ref_swiglu(const float* __restrict__ C, bf16* __restrict__ H) {
    const size_t n = (size_t)M * FFH;
    for (size_t i = (size_t)blockIdx.x * 256 + threadIdx.x; i < n; i += (size_t)gridDim.x * 256) { const size_t m = i / FFH; const int j = (int)(i % FFH), p = j >> 7, jj = j & 127;
        const float g = C[m * NGU + 256 * p + jj], u = C[m * NGU + 256 * p + 128 + jj]; H[i] = (bf16)f2bf(g / (1.0f + expf(-g)) * u); }
}
__global__ void __launch_bounds__(256) ref_convmul(const float* __restrict__ C, bf16* __restrict__ U, bf16* __restrict__ BG) {
    const size_t n = (size_t)M * DM;
    for (size_t i = (size_t)blockIdx.x * 256 + threadIdx.x; i < n; i += (size_t)gridDim.x * 256) { const size_t m = i / DM; const int c = (int)(i % DM), p = c >> 7, cc = c & 127;
        U[i] = (bf16)f2bf(C[m * NCI + 256 * p + cc] * C[m * NCI + 256 * p + 128 + cc]); BG[i] = (bf16)f2bf(C[m * NCI + 2 * DM + c]); }
}
__global__ void __launch_bounds__(256) ref_attn(const bf16* __restrict__ QK, const bf16* __restrict__ VT, const float* __restrict__ sinks, bf16* __restrict__ O) {
    const int lane = threadIdx.x & 63, gwv = blockIdx.x * 4 + (threadIdx.x >> 6); const int m = gwv >> 5, h = gwv & 31, b = m / SEQ, s = m % SEQ, g = h >> 2;
    const bf16* q = QK + (size_t)m * NQK + h * HD;
    const float q0 = bf2f(q[lane]), q1 = bf2f(q[64 + lane]);
    float sc[2]; bool ok[2]; int pos[2];
#pragma unroll
    for (int kk = 0; kk < 2; ++kk) { pos[kk] = s - 127 + lane + 64 * kk; ok[kk] = pos[kk] >= 0; const int pp = ok[kk] ? pos[kk] : 0;
        const bf16* kr = QK + (size_t)(b * SEQ + pp) * NQK + NQ + g * HD; float dot = 0.f;
        for (int d = 0; d < 64; ++d) dot += __shfl(q0, d) * bf2f(kr[d]);
        for (int d = 0; d < 64; ++d) dot += __shfl(q1, d) * bf2f(kr[64 + d]);
        sc[kk] = ok[kk] ? dot * 0.08838834764831845f : -INFINITY; }
    const float sink = sinks[h];
    float mx = fmaxf(sc[0], sc[1]);
#pragma unroll
    for (int o = 1; o < 64; o <<= 1) mx = fmaxf(mx, __shfl_xor(mx, o));
    mx = fmaxf(mx, sink);
    const float p0 = ok[0] ? expf(sc[0] - mx) : 0.f, p1 = ok[1] ? expf(sc[1] - mx) : 0.f;
    const float denom = wave_sum(p0 + p1) + expf(sink - mx);
    float o0 = 0.f, o1 = 0.f;
    const int pp0 = ok[0] ? pos[0] : 0, pp1 = ok[1] ? pos[1] : 0;
    for (int d = 0; d < 128; ++d) { const bf16* vr = VT + (size_t)(g * HD + d) * M + (size_t)b * SEQ;
        const float part = p0 * bf2f(vr[pp0]) + p1 * bf2f(vr[pp1]); const float tot = wave_sum(part);
        if (d < 64) { if (lane == d) o0 = tot; } else { if (lane == d - 64) o1 = tot; } }
    bf16* op = O + (size_t)m * NQ + h * HD; op[lane] = (bf16)f2bf(o0 / denom); op[64 + lane] = (bf16)f2bf(o1 / denom);
}
#endif

extern "C" void kernel_launch(void* const* d_in, const int* in_sizes, int n_in, void* d_out, int out_size, void* d_ws, size_t ws_size, hipStream_t stream) {
    static int grid = 0;
    if (grid == 0) {
        if (n_in != 13 || in_sizes[0] != M * DM || out_size != M * DM || ws_size < WS_END) { fprintf(stderr, "kernel_launch: shape/workspace mismatch (n_in %d, in0 %d, out %d, ws %zu < %zu); nothing launched\n", n_in, n_in > 0 ? in_sizes[0] : -1, out_size, ws_size, (size_t)WS_END); grid = -1; return; }
        int dev = 0, cus = 0, per_cu = 0;
        if (hipGetDevice(&dev) != hipSuccess || hipDeviceGetAttribute(&cus, hipDeviceAttributeMultiprocessorCount, dev) != hipSuccess) { fprintf(stderr, "kernel_launch: device query failed\n"); grid = -1; return; }
        if (hipFuncSetAttribute((const void*)mk_fwd, hipFuncAttributeMaxDynamicSharedMemorySize, LDS_BYTES) != hipSuccess) { fprintf(stderr, "kernel_launch: hipFuncSetAttribute failed\n"); grid = -1; return; }
        if (hipOccupancyMaxActiveBlocksPerMultiprocessor(&per_cu, (const void*)mk_fwd, NWAVES * 64, LDS_BYTES) != hipSuccess || per_cu < 1) fprintf(stderr, "kernel_launch: note: occupancy query reports %d workgroups per CU\n", per_cu);
        (void)hipGetLastError();
        grid = cus;
    }
    if (grid < 0) return;
    if (hipMemsetAsync((char*)d_ws + WS_CTL, 0, CTL_ZERO_BYTES, stream) != hipSuccess) { fprintf(stderr, "kernel_launch: memset failed\n"); return; }
    Args a{};
    for (int i = 0; i < 13; ++i) a.in[i] = (const float*)d_in[i];
    a.out = (float*)d_out; a.ws = (unsigned char*)d_ws;
#if !DEV_MODE
    a.ph_lo = 0; a.ph_hi = NPHASE; a.use_bar = 1;
    hipLaunchKernelGGL(mk_fwd, dim3(grid), dim3(NWAVES * 64), LDS_BYTES, stream, a);
    { const hipError_t le = hipPeekAtLastError(); if (le != hipSuccess) fprintf(stderr, "kernel_launch: launch failed: %s\n", hipGetErrorName(le)); }
#else
    unsigned char* ws = (unsigned char*)d_ws;
    bf16* XB = (bf16*)(ws + WS_XB); bf16* QKb = (bf16*)(ws + WS_QK); bf16* VTb = (bf16*)(ws + WS_VT); bf16* Ob = (bf16*)(ws + WS_O); bf16* Yh = (bf16*)(ws + WS_Y); bf16* XH = (bf16*)(ws + WS_X); float* STf = (float*)(ws + WS_ST);
    bf16* Hb = (bf16*)(ws + WS_H); bf16* Ub = (bf16*)(ws + WS_U); bf16* BGb = (bf16*)(ws + WS_BG); float* Cf = (float*)(ws + WS_C);
    for (int p = 0; p < NPHASE; ++p) {
        const int layer = p >= 8 ? 1 : 0, q = p == 0 ? -1 : (p - 1) % 7;
        const bool shared = (p == 0) || q == 3 || q == 6 || p == 9;
        if (shared || ((FASTMASK >> p) & 1u)) { a.ph_lo = p; a.ph_hi = p + 1; a.use_bar = 0; hipLaunchKernelGGL(mk_fwd, dim3(grid), dim3(NWAVES * 64), LDS_BYTES, stream, a); continue; }
        if (p == 1) { hipLaunchKernelGGL(ref_gemm<true>, dim3(NQK / 128, M / 128), dim3(256), 0, stream, XB, (const bf16*)(ws + WS_WQKV), (void*)QKb, M, NQK, DM, NQK);
                      hipLaunchKernelGGL(ref_gemm<true>, dim3(M / 128, NKV / 128), dim3(256), 0, stream, (const bf16*)(ws + WS_WV), XB, (void*)VTb, NKV, M, DM, M); }
        else if (p == 2) hipLaunchKernelGGL(ref_attn, dim3(M * NHEAD / 4), dim3(256), 0, stream, QKb, VTb, (const float*)d_in[2], Ob);
        else if (p == 8) { hipLaunchKernelGGL(ref_gemm<false>, dim3(NCI / 128, M / 128), dim3(256), 0, stream, XB, (const bf16*)(ws + WS_WCI), (void*)Cf, M, NCI, DM, NCI);
                           hipLaunchKernelGGL(ref_convmul, dim3(4096), dim3(256), 0, stream, Cf, Ub, BGb); }
        else if (q == 2) { hipLaunchKernelGGL(ref_gemm<false>, dim3(DM / 128, M / 128), dim3(256), 0, stream, Ob, (const bf16*)(ws + (layer ? WS_WCO : WS_WO)), (void*)Cf, M, DM, DM, DM);
                           if (layer == 0) hipLaunchKernelGGL(ref_res, dim3(4096), dim3(256), 0, stream, Cf, (const bf16*)XH, Yh, ALPHA, (size_t)M * DM);
                           else hipLaunchKernelGGL(ref_res_ln, dim3(4096), dim3(256), 0, stream, Cf, Yh, (const float*)STf, (const float*)d_in[11], (const float*)d_in[12], ALPHA, (size_t)M * DM); }
        else if (q == 4) { hipLaunchKernelGGL(ref_gemm<false>, dim3(NGU / 128, M / 128), dim3(256), 0, stream, XB, (const bf16*)(ws + (layer ? WS_WGU1 : WS_WGU0)), (void*)Cf, M, NGU, DM, NGU);
                           hipLaunchKernelGGL(ref_swiglu, dim3(8192), dim3(256), 0, stream, Cf, Hb); }
        else if (q == 5) { hipLaunchKernelGGL(ref_gemm<false>, dim3(DM / 128, M / 128), dim3(256), 0, stream, Hb, (const bf16*)(ws + (layer ? WS_WD1 : WS_WD0)), (void*)Cf, M, DM, FFH, DM);
                           hipLaunchKernelGGL(ref_res_ln, dim3(4096), dim3(256), 0, stream, Cf, Yh, (const float*)STf, (const float*)d_in[7] + layer * DM, (const float*)d_in[8] + layer * DM, ALPHA, (size_t)M * DM); }
    }
    { const hipError_t le = hipPeekAtLastError(); if (le != hipSuccess) fprintf(stderr, "kernel_launch: a launch failed: %s\n", hipGetErrorName(le)); }
#endif
}
```
